# Optimizing an MI355X kernel written in HIP

```python
import math
import jax, jax.numpy as jnp
from jax import lax
import numpy as np

D_MODEL = 1024
BATCH = 2
SEQ = 8192
DEPTH = 4

HEAD_DIM = 128
N_Q_HEADS = 8
N_KV_HEADS = 2
Q_PER_KV = N_Q_HEADS // N_KV_HEADS
ATTN_WIDTH = N_Q_HEADS * HEAD_DIM
KV_WIDTH = N_KV_HEADS * HEAD_DIM
WINDOW = 128
BLOCK = 128
ROPE_THETA = 10000.0

D_RNN = D_MODEL
N_RNN_BLOCKS = 8
RNN_BLOCK_W = D_RNN // N_RNN_BLOCKS
CONV_W = 4
LRU_C = 8.0

N_IN = ATTN_WIDTH + 2 * KV_WIDTH + 2 * D_RNN + 2 * D_MODEL
SPLITS = [ATTN_WIDTH,
          ATTN_WIDTH + KV_WIDTH,
          ATTN_WIDTH + 2 * KV_WIDTH,
          ATTN_WIDTH + 2 * KV_WIDTH + D_RNN,
          ATTN_WIDTH + 2 * KV_WIDTH + 2 * D_RNN,
          ATTN_WIDTH + 2 * KV_WIDTH + 2 * D_RNN + D_MODEL]

N_GROUPS = 4
EXPERTS_PER_GROUP = 8
N_EXPERTS = N_GROUPS * EXPERTS_PER_GROUP
TOP_K = 2
D_EXPERT = 512
MOE_BLOCK = 128

ALPHA = (2 * DEPTH) ** 0.25
BETA = (8 * DEPTH) ** -0.25
LN_EPS = 1e-5

kernel_name = "hybrid_gqa_rglru_hmoe_encoder"


def layer_norm(x, g, b):
    xf = x.astype(jnp.float32)
    mu = xf.mean(-1, keepdims=True)
    var = jnp.square(xf - mu).mean(-1, keepdims=True)
    y = (xf - mu) * lax.rsqrt(var + LN_EPS) * g.astype(jnp.float32) + b.astype(jnp.float32)
    return y.astype(x.dtype)


def rope(t):
    S = t.shape[1]
    inv = ROPE_THETA ** (-jnp.arange(0, HEAD_DIM, 2, dtype=jnp.float32) / HEAD_DIM)
    ang = jnp.arange(S, dtype=jnp.float32)[:, None] * inv[None, :]
    cos = jnp.cos(ang)[None, :, None, :]
    sin = jnp.sin(ang)[None, :, None, :]
    tf = t.astype(jnp.float32)
    t1, t2 = tf[..., : HEAD_DIM // 2], tf[..., HEAD_DIM // 2:]
    return jnp.concatenate([t1 * cos - t2 * sin, t2 * cos + t1 * sin], axis=-1).astype(t.dtype)


def window_attention(q, k, v, sink):
    B, S = q.shape[0], q.shape[1]
    nb = S // BLOCK
    qb = q.reshape(B, nb, BLOCK, N_KV_HEADS, Q_PER_KV, HEAD_DIM)

    def neighbours(t):
        tp = jnp.pad(t, ((0, 0), (BLOCK, BLOCK), (0, 0), (0, 0)))
        tp = tp.reshape(B, nb + 2, BLOCK, N_KV_HEADS, HEAD_DIM)
        return jnp.concatenate([tp[:, :-2], tp[:, 1:-1], tp[:, 2:]], axis=2)

    kw, vw = neighbours(k), neighbours(v)
    s = jnp.einsum('bnqhgd,bnkhd->bnhgqk', qb, kw,
                   preferred_element_type=jnp.float32) * (HEAD_DIM ** -0.5)
    qi = jnp.arange(BLOCK)[:, None]
    kj = jnp.arange(3 * BLOCK)[None, :]
    rel = kj - BLOCK - qi
    kpos = jnp.arange(nb)[:, None, None] * BLOCK + kj[None] - BLOCK
    mask = (jnp.abs(rel) <= WINDOW)[None] & (kpos >= 0) & (kpos < S)
    s = jnp.where(mask[None, :, None, None], s, -1e30)
    sk = sink.astype(jnp.float32).reshape(1, 1, N_KV_HEADS, Q_PER_KV, 1, 1)
    m = jnp.maximum(s.max(-1, keepdims=True), sk)
    p = jnp.exp(s - m)
    denom = p.sum(-1, keepdims=True) + jnp.exp(sk - m)
    p = (p / denom).astype(v.dtype)
    o = jnp.einsum('bnhgqk,bnkhd->bnqhgd', p, vw)
    return o.reshape(B, S, ATTN_WIDTH)


def centred_conv(x, w, b):
    S = x.shape[1]
    left = CONV_W // 2
    xp = jnp.pad(x, ((0, 0), (left, CONV_W - 1 - left), (0, 0)))
    y = xp[:, 0:S] * w[0]
    for tap in range(1, CONV_W):
        y = y + xp[:, tap:tap + S] * w[tap]
    return y + b


def block_diag(x, w, b):
    B, S = x.shape[0], x.shape[1]
    y = jnp.einsum('bsnc,ncd->bsnd', x.reshape(B, S, N_RNN_BLOCKS, RNN_BLOCK_W), w)
    return y.reshape(B, S, D_RNN) + b


def linear_scan(a, u):
    def comb(left, right):
        a1, b1 = left
        a2, b2 = right
        return a1 * a2, a2 * b1 + b2
    _, h = lax.associative_scan(comb, (a, u), axis=1)
    return h


def rg_lru(xc, w_r, b_r, w_i, b_i, lam, reverse):
    r = jax.nn.sigmoid(block_diag(xc, w_r, b_r).astype(jnp.float32))
    i = jax.nn.sigmoid(block_diag(xc, w_i, b_i).astype(jnp.float32))
    log_a = -LRU_C * r * jax.nn.softplus(-lam.astype(jnp.float32))
    a = jnp.exp(log_a)
    mult = jnp.sqrt(-jnp.expm1(2.0 * log_a))
    u = xc.astype(jnp.float32) * i * mult
    if reverse:
        h = jnp.flip(linear_scan(jnp.flip(a, 1), jnp.flip(u, 1)), 1)
    else:
        h = linear_scan(a, u)
    return h


def mixer(x, w_in, w_sink, w_conv, b_conv, w_rec_gate, b_rec_gate, w_in_gate, b_in_gate,
          lru_lambda, w_attn_o, w_rnn_o, w_out):
    B, S = x.shape[0], x.shape[1]
    z = x @ w_in
    q, k, v, xr, yr, ga, gr = jnp.split(z, SPLITS, axis=-1)
    q = rope(q.reshape(B, S, N_Q_HEADS, HEAD_DIM))
    k = rope(k.reshape(B, S, N_KV_HEADS, HEAD_DIM))
    v = v.reshape(B, S, N_KV_HEADS, HEAD_DIM)
    y_attn = window_attention(q, k, v, w_sink) @ w_attn_o

    xc = centred_conv(xr, w_conv, b_conv)
    h = (rg_lru(xc, w_rec_gate[0], b_rec_gate[0], w_in_gate[0], b_in_gate[0], lru_lambda[0], False)
         + rg_lru(xc, w_rec_gate[1], b_rec_gate[1], w_in_gate[1], b_in_gate[1], lru_lambda[1], True))
    y_rnn = (h.astype(x.dtype) * jax.nn.gelu(yr, approximate=True)) @ w_rnn_o

    merged = jax.nn.sigmoid(ga) * y_attn + jax.nn.sigmoid(gr) * y_rnn
    return merged @ w_out


def hier_moe(x, w_rg, b_rg, w_re, b_re, w_g, w_u, w_d):
    B, S, D = x.shape
    T = B * S
    xt = x.reshape(T, D)
    g_prob = jax.nn.softmax((xt @ w_rg + b_rg).astype(jnp.float32), axis=-1)
    g_val, g_idx = lax.top_k(g_prob, 1)
    e_logits = (xt @ w_re + b_re).astype(jnp.float32).reshape(T, N_GROUPS, EXPERTS_PER_GROUP)
    e_in_group = jnp.take_along_axis(e_logits, g_idx[:, :, None], axis=1)[:, 0]
    top_l, top_i = lax.top_k(e_in_group, TOP_K)
    gate = jax.nn.softmax(top_l, axis=-1) * g_val

    eid = (g_idx * EXPERTS_PER_GROUP + top_i).reshape(-1)
    tok = jnp.repeat(jnp.arange(T, dtype=jnp.int32), TOP_K)
    wt = gate.reshape(-1).astype(x.dtype)
    n_assign = T * TOP_K
    order = jnp.argsort(eid)
    se = eid[order]
    counts = jnp.bincount(eid, length=N_EXPERTS)
    starts = jnp.cumsum(counts) - counts
    pcounts = (counts + MOE_BLOCK - 1) // MOE_BLOCK * MOE_BLOCK
    pends = jnp.cumsum(pcounts)
    pstarts = pends - pcounts
    dest = pstarts[se] + jnp.arange(n_assign, dtype=jnp.int32) - starts[se]
    n_blocks = -(-n_assign // MOE_BLOCK) + N_EXPERTS
    n_rows = n_blocks * MOE_BLOCK
    buf_tok = jnp.full((n_rows,), T, jnp.int32).at[dest].set(tok[order])
    buf_w = jnp.zeros((n_rows,), x.dtype).at[dest].set(wt[order])
    block_e = jnp.minimum(jnp.searchsorted(pends, jnp.arange(n_blocks) * MOE_BLOCK, side='right'),
                          N_EXPERTS - 1)
    x_pad = jnp.concatenate([xt, jnp.zeros((1, D), xt.dtype)], axis=0)
    xb = x_pad[buf_tok].reshape(n_blocks, MOE_BLOCK, D)

    def expert_block(args):
        xblk, e = args
        hid = jax.nn.silu(xblk @ w_g[e]) * (xblk @ w_u[e])
        return hid @ w_d[e]

    yb = lax.map(expert_block, (xb, block_e)).reshape(n_rows, D) * buf_w[:, None]
    out = jnp.zeros((T + 1, D), x.dtype).at[buf_tok].add(yb)[:T]
    return out.reshape(B, S, D)


def setup_inputs(seed: int = 0) -> dict:
    key = jax.random.key(seed)
    ks = jax.random.split(key, 24)
    f32 = jnp.float32

    def nrm(k, shape, scale):
        return jax.random.normal(k, shape, f32) * scale

    x = nrm(ks[0], (BATCH, SEQ, D_MODEL), 1.0)
    col_scale = jnp.concatenate([jnp.ones((ATTN_WIDTH + KV_WIDTH,), f32),
                                 jnp.full((KV_WIDTH,), BETA, f32),
                                 jnp.ones((2 * D_RNN + 2 * D_MODEL,), f32)])
    w_in = nrm(ks[1], (DEPTH, D_MODEL, N_IN), D_MODEL ** -0.5) * col_scale
    w_sink = nrm(ks[2], (DEPTH, N_Q_HEADS), 0.5)
    w_conv = nrm(ks[3], (DEPTH, CONV_W, D_RNN), CONV_W ** -0.5)
    b_conv = nrm(ks[4], (DEPTH, D_RNN), 0.02)
    w_rec_gate = nrm(ks[5], (DEPTH, 2, N_RNN_BLOCKS, RNN_BLOCK_W, RNN_BLOCK_W), RNN_BLOCK_W ** -0.5)
    b_rec_gate = nrm(ks[6], (DEPTH, 2, D_RNN), 0.02)
    w_in_gate = nrm(ks[7], (DEPTH, 2, N_RNN_BLOCKS, RNN_BLOCK_W, RNN_BLOCK_W), RNN_BLOCK_W ** -0.5)
    b_in_gate = nrm(ks[8], (DEPTH, 2, D_RNN), 0.02)
    u = jax.random.uniform(ks[9], (DEPTH, 2, D_RNN), f32, 0.9, 0.999)
    s = u ** (1.0 / LRU_C)
    lru_lambda = jnp.log(s) - jnp.log1p(-s)
    w_attn_o = nrm(ks[10], (DEPTH, ATTN_WIDTH, D_MODEL), ATTN_WIDTH ** -0.5 * BETA)
    w_rnn_o = nrm(ks[11], (DEPTH, D_RNN, D_MODEL), D_RNN ** -0.5 * BETA)
    w_out = nrm(ks[12], (DEPTH, D_MODEL, D_MODEL), D_MODEL ** -0.5 * BETA)
    ln_g = 1.0 + nrm(ks[13], (DEPTH, 2, D_MODEL), 0.02)
    ln_b = nrm(ks[14], (DEPTH, 2, D_MODEL), 0.02)
    w_router_group = nrm(ks[15], (DEPTH, D_MODEL, N_GROUPS), D_MODEL ** -0.5)
    b_router_group = nrm(ks[16], (DEPTH, N_GROUPS), 0.01)
    w_router_expert = nrm(ks[17], (DEPTH, D_MODEL, N_EXPERTS), D_MODEL ** -0.5)
    b_router_expert = nrm(ks[18], (DEPTH, N_EXPERTS), 0.01)
    w_exp_gate = nrm(ks[19], (DEPTH, N_EXPERTS, D_MODEL, D_EXPERT), D_MODEL ** -0.5)
    w_exp_up = nrm(ks[20], (DEPTH, N_EXPERTS, D_MODEL, D_EXPERT), D_MODEL ** -0.5 * BETA)
    w_exp_down = nrm(ks[21], (DEPTH, N_EXPERTS, D_EXPERT, D_MODEL), D_EXPERT ** -0.5 * BETA)
    return {"x": x, "w_in": w_in, "w_sink": w_sink, "w_conv": w_conv, "b_conv": b_conv,
            "w_rec_gate": w_rec_gate, "b_rec_gate": b_rec_gate,
            "w_in_gate": w_in_gate, "b_in_gate": b_in_gate, "lru_lambda": lru_lambda,
            "w_attn_o": w_attn_o, "w_rnn_o": w_rnn_o, "w_out": w_out,
            "ln_g": ln_g, "ln_b": ln_b,
            "w_router_group": w_router_group, "b_router_group": b_router_group,
            "w_router_expert": w_router_expert, "b_router_expert": b_router_expert,
            "w_exp_gate": w_exp_gate, "w_exp_up": w_exp_up, "w_exp_down": w_exp_down}


def reference(x, w_in, w_sink, w_conv, b_conv, w_rec_gate, b_rec_gate, w_in_gate, b_in_gate,
              lru_lambda, w_attn_o, w_rnn_o, w_out, ln_g, ln_b,
              w_router_group, b_router_group, w_router_expert, b_router_expert,
              w_exp_gate, w_exp_up, w_exp_down):
    for l in range(DEPTH):
        mix = mixer(x, w_in[l], w_sink[l], w_conv[l], b_conv[l], w_rec_gate[l], b_rec_gate[l],
                    w_in_gate[l], b_in_gate[l], lru_lambda[l], w_attn_o[l], w_rnn_o[l], w_out[l])
        x = layer_norm(ALPHA * x + mix, ln_g[l, 0], ln_b[l, 0])
        ffn = hier_moe(x, w_router_group[l], b_router_group[l], w_router_expert[l], b_router_expert[l],
                       w_exp_gate[l], w_exp_up[l], w_exp_down[l])
        x = layer_norm(ALPHA * x + ffn, ln_g[l, 1], ln_b[l, 1])
    return x
```

```cpp
#include <hip/hip_runtime.h>
#include <hip/hip_bf16.h>
#include <cstdio>
#include <cstdint>

#ifndef MK_ONE_LAUNCH
#define MK_ONE_LAUNCH 1
#endif
#ifndef EN_ATTN
#define EN_ATTN 1
#endif
#ifndef EN_RNN
#define EN_RNN 1
#endif
#ifndef EN_MOE
#define EN_MOE 1
#endif

constexpr int DM = 1024, NBATCH = 2, SEQ = 8192, TOK = NBATCH * SEQ, DEPTH = 4;
constexpr int HD = 128, NQH = 8, NKVH = 2, KVW = NKVH * HD, WIN = 128;
constexpr int NIN = 5632;
constexpr int NEXP = 32, DEXP = 512, MOE_ROWS_MAX = 40960, MOE_TILES_MAX = 160;
constexpr float ALPHA = 1.6817928305074292f;
constexpr float LN_EPS = 1e-5f;
constexpr int CHUNK = 128, NCHUNK = SEQ / CHUNK;

__device__ __forceinline__ float bperm_f(int srclane, float v) { return __builtin_bit_cast(float, __builtin_amdgcn_ds_bpermute(srclane << 2, __builtin_bit_cast(int, v))); }

namespace pg8 {
#define PG8_LAS __attribute__((address_space(3)))
typedef unsigned short bf16_t;
typedef short bf16x8 __attribute__((ext_vector_type(8)));
typedef float f32x4 __attribute__((ext_vector_type(4)));
typedef unsigned u32x4 __attribute__((ext_vector_type(4)));
constexpr int BM = 256, BK = 64, HALF = 128, HTB = HALF * BK * 2  , STAGE_BYTES = 8 * HTB, NXCD = 8, WGM = 8;

__host__ __device__ __forceinline__ int lds_byte(int r, int c) { const int st = (r >> 4) * 2 + (c >> 5), rr = r & 15, cc = c & 31, ob = rr * 64 + cc * 2; return st * 1024 + (ob ^ (((ob >> 9) & 1) << 5)); }
__host__ __device__ __forceinline__ void stage_rc(int b, int& R, int& C) { const int st = b / 1024, sb = b % 1024, swz = sb ^ (((sb >> 9) & 1) << 5); R = (st >> 1) * 16 + swz / 64; C = (st & 1) * 32 + (swz % 64) / 2; }
__host__ __device__ __forceinline__ int perm32(int rho) { const int n = rho >> 4, i = rho & 15; return 8 * (i >> 2) + 4 * n + (i & 3); }

struct Unit { int pm, pn; };
struct Gemm { const bf16_t* A; const bf16_t* Bt; int M, N, K; };

struct StaticOrder {
    int nM, nN, nwg, G, c;
    __host__ __device__ void init(int M, int N, int G_, int c_) { nM = M / BM; nN = N / BM; nwg = nM * nN; G = G_; c = c_; }
    __host__ __device__ bool next(int i, Unit& u) const {
        const long L = (long)i * G + c; if (L >= nwg) return false;
        int wgid = (int)L; { const int q = nwg / NXCD, r = nwg % NXCD, xcd = wgid % NXCD, off = wgid / NXCD; wgid = (xcd < r ? xcd * (q + 1) : r * (q + 1) + (xcd - r) * q) + off; }
        const int nig = WGM * nN, gid = wgid / nig, fm = gid * WGM, gsz = (nM - fm) < WGM ? (nM - fm) : WGM;
        u.pm = fm + ((wgid % nig) % gsz); u.pn = (wgid % nig) / gsz; return true;
    }
    __device__ __forceinline__ void a_ready(const Unit&) const {}
    __device__ __forceinline__ void done(const Unit&) const {}
};

__device__ __forceinline__ unsigned cvt_pk_bf16(float lo, float hi) { unsigned r; asm volatile("v_cvt_pk_bf16_f32 %0, %1, %2" : "=v"(r) : "v"(lo), "v"(hi)); return r; }
typedef float f32x2 __attribute__((ext_vector_type(2)));
__device__ __forceinline__ f32x2 gelu_pk(f32x2 v) {
    const f32x2 av = __builtin_elementwise_abs(v), d = av * 0.2316418882f + 1.0f;
    f32x2 t; t.x = __builtin_amdgcn_rcpf(d.x); t.y = __builtin_amdgcn_rcpf(d.y);
    f32x2 q = t * 0.5307027145f + (-0.7265760135f); q = q * t + 0.7107068705f; q = q * t + (-0.142248368f); q = q * t + 0.127414796f; q = q * t;
    const f32x2 s = (v * v) * (-0.72134752044f);
    f32x2 e; e.x = __builtin_amdgcn_exp2f(s.x); e.y = __builtin_amdgcn_exp2f(s.y);
    const f32x2 m = v * (q * e), r = v - m;
    f32x2 o; o.x = v.x < 0.f ? m.x : r.x; o.y = v.y < 0.f ? m.y : r.y; return o;
}

typedef unsigned u32x2 __attribute__((ext_vector_type(2)));
__device__ __forceinline__ float bf_lo(unsigned w) { return __builtin_bit_cast(float, w << 16); }
__device__ __forceinline__ float bf_hi(unsigned w) { return __builtin_bit_cast(float, w & 0xffff0000u); }
__device__ __forceinline__ float sigmoid_f(float x) { return __builtin_amdgcn_rcpf(1.0f + __builtin_amdgcn_exp2f(-1.4426950408889634f * x)); }
__device__ __forceinline__ float gelu_tanh_f(float x) { const float z2 = 1.5957691216057308f * (x + 0.044715f * x * x * x); return x * sigmoid_f(z2); }
__device__ __forceinline__ u32x4 pack8f(f32x4 a, f32x4 b) { u32x4 w; w.x = cvt_pk_bf16(a[0], a[1]); w.y = cvt_pk_bf16(a[2], a[3]); w.z = cvt_pk_bf16(b[0], b[1]); w.w = cvt_pk_bf16(b[2], b[3]); return w; }

struct EpiInProj {
    static constexpr bool PERM = true, AFTER_DRAIN = false;
    bf16_t *Q, *K, *V, *XR, *YG, *GA, *GR; const float* rcos; const float* rsin;
    __device__ __forceinline__ void operator()(const f32x4 (&acc)[2][2][4][2], const Unit& u, int wr, int wc, int fr, int fq) const {
        const int pn = u.pn, row0 = u.pm * BM + wr * 64 + fr, cl = wc * 32 + 8 * fq;
        if (pn < 5) {
            bf16_t* base = pn < 4 ? Q + pn * 256 : K; const int ld = pn < 4 ? 1024 : 256; const int d0 = 16 * wc + 4 * fq;
#pragma unroll
            for (int ai = 0; ai < 2; ++ai)
#pragma unroll
                for (int m = 0; m < 4; ++m) { const int row = row0 + ai * HALF + m * 16, t = row & 8191;
                    const f32x4 cs = *(const f32x4*)(rcos + t * 64 + d0), sn = *(const f32x4*)(rsin + t * 64 + d0);
#pragma unroll
                    for (int bj = 0; bj < 2; ++bj) { const f32x4 x1 = acc[ai][bj][m][0], x2 = acc[ai][bj][m][1];
                        const f32x4 o1 = x1 * cs - x2 * sn, o2 = x2 * cs + x1 * sn;
                        *(u32x4*)(base + (size_t)row * ld + bj * HALF + cl) = pack8f(o1, o2); } }
        } else {
            bf16_t* base; int ld = 1024, act = 0;
            if (pn == 5) { base = V; ld = 256; }
            else if (pn < 10) { base = XR + (pn - 6) * 256; }
            else if (pn < 14) { base = YG + (pn - 10) * 256; act = 1; }
            else if (pn < 18) { base = GA + (pn - 14) * 256; act = 2; }
            else { base = GR + (pn - 18) * 256; act = 2; }
#pragma unroll
            for (int ai = 0; ai < 2; ++ai)
#pragma unroll
                for (int m = 0; m < 4; ++m) { const int row = row0 + ai * HALF + m * 16;
#pragma unroll
                    for (int bj = 0; bj < 2; ++bj) { f32x4 v0 = acc[ai][bj][m][0], v1 = acc[ai][bj][m][1];
                        if (act == 1) {
#pragma unroll
                            for (int e = 0; e < 4; ++e) { v0[e] = gelu_tanh_f(v0[e]); v1[e] = gelu_tanh_f(v1[e]); } }
                        else if (act == 2) {
#pragma unroll
                            for (int e = 0; e < 4; ++e) { v0[e] = sigmoid_f(v0[e]); v1[e] = sigmoid_f(v1[e]); } }
                        *(u32x4*)(base + (size_t)row * ld + bj * HALF + cl) = pack8f(v0, v1); } }
        }
    }
};
struct EpiGate {
    static constexpr bool PERM = true, AFTER_DRAIN = false;
    const bf16_t* gate; const bf16_t* add; bf16_t* out;
    __device__ __forceinline__ void operator()(const f32x4 (&acc)[2][2][4][2], const Unit& u, int wr, int wc, int fr, int fq) const {
        const int row0 = u.pm * BM + wr * 64 + fr, col0 = u.pn * BM + wc * 32 + 8 * fq;
#pragma unroll
        for (int ai = 0; ai < 2; ++ai)
#pragma unroll
            for (int m = 0; m < 4; ++m) { const size_t ro = (size_t)(row0 + ai * HALF + m * 16) * 1024 + col0;
#pragma unroll
                for (int bj = 0; bj < 2; ++bj) { const u32x4 g = *(const u32x4*)(gate + ro + bj * HALF);
                    f32x4 v0 = acc[ai][bj][m][0], v1 = acc[ai][bj][m][1];
                    v0[0] *= bf_lo(g.x); v0[1] *= bf_hi(g.x); v0[2] *= bf_lo(g.y); v0[3] *= bf_hi(g.y);
                    v1[0] *= bf_lo(g.z); v1[1] *= bf_hi(g.z); v1[2] *= bf_lo(g.w); v1[3] *= bf_hi(g.w);
                    if (add) { const u32x4 a = *(const u32x4*)(add + ro + bj * HALF);
                        v0[0] += bf_lo(a.x); v0[1] += bf_hi(a.x); v0[2] += bf_lo(a.y); v0[3] += bf_hi(a.y);
                        v1[0] += bf_lo(a.z); v1[1] += bf_hi(a.z); v1[2] += bf_lo(a.w); v1[3] += bf_hi(a.w); }
                    *(u32x4*)(out + ro + bj * HALF) = pack8f(v0, v1); } }
    }
};
struct EpiResid {
    static constexpr bool PERM = false, AFTER_DRAIN = false;
    const float* xin; float* out; float alpha;
    __device__ __forceinline__ void operator()(const f32x4 (&acc)[2][2][4][2], const Unit& u, int wr, int wc, int fr, int fq) const {
        const int row0 = u.pm * BM + wr * 64 + fr, col0 = u.pn * BM + wc * 32 + 4 * fq;
#pragma unroll
        for (int ai = 0; ai < 2; ++ai)
#pragma unroll
            for (int m = 0; m < 4; ++m) { const size_t ro = (size_t)(row0 + ai * HALF + m * 16) * 1024 + col0;
#pragma unroll
                for (int bj = 0; bj < 2; ++bj)
#pragma unroll
                    for (int n = 0; n < 2; ++n) { const f32x4 xv = *(const f32x4*)(xin + ro + bj * HALF + n * 16);
                        *(f32x4*)(out + ro + bj * HALF + n * 16) = xv * alpha + acc[ai][bj][m][n]; } }
    }
};
struct EpiSwiGLU {
    static constexpr bool PERM = true, AFTER_DRAIN = false;
    bf16_t* hid;
    __device__ __forceinline__ void operator()(const f32x4 (&acc)[2][2][4][2], const Unit& u, int wr, int wc, int fr, int fq) const {
        const int row0 = u.pm * BM + wr * 64 + fr, col0 = (u.pn & 3) * 128 + wc * 32 + 8 * fq;
#pragma unroll
        for (int ai = 0; ai < 2; ++ai)
#pragma unroll
            for (int m = 0; m < 4; ++m) { f32x4 h0, h1;
#pragma unroll
                for (int e = 0; e < 4; ++e) { const float g0 = acc[ai][0][m][0][e], g1 = acc[ai][0][m][1][e];
                    h0[e] = g0 * sigmoid_f(g0) * acc[ai][1][m][0][e]; h1[e] = g1 * sigmoid_f(g1) * acc[ai][1][m][1][e]; }
                *(u32x4*)(hid + (size_t)(row0 + ai * HALF + m * 16) * 512 + col0) = pack8f(h0, h1); }
    }
};
struct EpiDown {
    static constexpr bool PERM = true, AFTER_DRAIN = false;
    const int* slot; const float* roww; bf16_t* yb;
    __device__ __forceinline__ void operator()(const f32x4 (&acc)[2][2][4][2], const Unit& u, int wr, int wc, int fr, int fq) const {
        const int row0 = u.pm * BM + wr * 64 + fr, col0 = (u.pn & 3) * 256 + wc * 32 + 8 * fq;
#pragma unroll
        for (int ai = 0; ai < 2; ++ai)
#pragma unroll
            for (int m = 0; m < 4; ++m) { const int row = row0 + ai * HALF + m * 16; const int s = slot[row]; const float w = roww[row];
                if (s >= 0) {
#pragma unroll
                    for (int bj = 0; bj < 2; ++bj) *(u32x4*)(yb + (size_t)s * 1024 + col0 + bj * HALF) = pack8f(acc[ai][bj][m][0] * w, acc[ai][bj][m][1] * w); } }
    }
};
struct PanelStats {
    unsigned* xbuf;
    unsigned* cnt;
    unsigned* tmo;
    int ntn; float eps;
    unsigned code;
    __device__ __forceinline__ bool run(const f32x4 (&v)[2][2][4][2], const Unit& u, int wr, int wc, int fr, int fq, PG8_LAS unsigned char* lds, int wid, int lane) const {
        typedef float f32x2v __attribute__((ext_vector_type(2)));
        PG8_LAS f32x2v* P = (PG8_LAS f32x2v*)lds;
        PG8_LAS f32x2v* S = (PG8_LAS f32x2v*)(lds + 8192);
        PG8_LAS unsigned* flag = (PG8_LAS unsigned*)(lds + 8192 + 2048);
#pragma unroll
        for (int ai = 0; ai < 2; ++ai)
#pragma unroll
            for (int m = 0; m < 4; ++m) {
                float s = 0.f;
#pragma unroll
                for (int bj = 0; bj < 2; ++bj)
#pragma unroll
                    for (int n = 0; n < 2; ++n) { const f32x4 x = v[ai][bj][m][n]; s += (x[0] + x[1]) + (x[2] + x[3]); }
                s += bperm_f(lane ^ 16, s); s += bperm_f(lane ^ 32, s);
                const float mw = s * (1.0f / 64.0f); float q = 0.f;
#pragma unroll
                for (int bj = 0; bj < 2; ++bj)
#pragma unroll
                    for (int n = 0; n < 2; ++n) { const f32x4 d = v[ai][bj][m][n] - mw; q += (d[0] * d[0] + d[1] * d[1]) + (d[2] * d[2] + d[3] * d[3]); }
                q += bperm_f(lane ^ 16, q); q += bperm_f(lane ^ 32, q);
                if (fq == 0) P[(ai * HALF + wr * 64 + m * 16 + fr) * 4 + wc] = (f32x2v){mw, q};
            }
        asm volatile("s_waitcnt lgkmcnt(0)" ::: "memory"); __builtin_amdgcn_s_barrier(); asm volatile("" ::: "memory");
        const int row = wid * 32 + (lane & 31);
        if (lane < 32) {
            const f32x2v a = P[row * 4 + 0], b = P[row * 4 + 1], c = P[row * 4 + 2], d = P[row * 4 + 3];
            const float mt = (a.x + b.x + c.x + d.x) * 0.25f;
            const float da = a.x - mt, db = b.x - mt, dc = c.x - mt, dd = d.x - mt;
            const float m2 = (a.y + b.y) + (c.y + d.y) + 64.0f * ((da * da + db * db) + (dc * dc + dd * dd));
            unsigned long long* slot = (unsigned long long*)xbuf + ((size_t)(u.pm * BM + row) * 4 + u.pn);
            __hip_atomic_store(slot, ((unsigned long long)__float_as_uint(m2) << 32) | __float_as_uint(mt), __ATOMIC_RELAXED, __HIP_MEMORY_SCOPE_AGENT);
        }
        asm volatile("s_waitcnt vmcnt(0)" ::: "memory");
        if (lane == 0) __hip_atomic_fetch_add(cnt + 64 * u.pm, 1u, __ATOMIC_RELAXED, __HIP_MEMORY_SCOPE_AGENT);
        if (wid == 0) {
            bool dead = false; const unsigned long long t0 = __builtin_amdgcn_s_memrealtime(); const unsigned want = 8u * (unsigned)ntn;
            for (;;) {
                if ((unsigned)__builtin_amdgcn_readfirstlane(__hip_atomic_load(cnt + 64 * u.pm, __ATOMIC_RELAXED, __HIP_MEMORY_SCOPE_AGENT)) >= want) break;
                if (__builtin_amdgcn_s_memrealtime() - t0 > 2000000ull) {
                    if (lane == 0) { unsigned expect = 0u; __hip_atomic_compare_exchange_strong(tmo + 1, &expect, code | (unsigned)(u.pm & 0xff), __ATOMIC_RELAXED, __ATOMIC_RELAXED, __HIP_MEMORY_SCOPE_AGENT);
                                     __hip_atomic_store(tmo, 1u, __ATOMIC_RELAXED, __HIP_MEMORY_SCOPE_AGENT); }
                    dead = true; break; }
                __builtin_amdgcn_s_sleep(2);
            }
            __builtin_amdgcn_fence(__ATOMIC_ACQUIRE, "agent");
            if (lane == 0) flag[0] = dead ? 1u : 0u;
        }
        asm volatile("s_waitcnt vmcnt(0) lgkmcnt(0)" ::: "memory"); __builtin_amdgcn_s_barrier(); asm volatile("" ::: "memory");
        const bool bad = flag[0] != 0u;
        if (lane < 32) {
            const unsigned long long* slot = (const unsigned long long*)xbuf + (size_t)(u.pm * BM + row) * 4; float mt[4], m2[4]; float ms = 0.f;
#pragma unroll
            for (int t = 0; t < 4; ++t) { if (t < ntn) { const unsigned long long w = __hip_atomic_load(slot + t, __ATOMIC_RELAXED, __HIP_MEMORY_SCOPE_AGENT); mt[t] = __uint_as_float((unsigned)w); m2[t] = __uint_as_float((unsigned)(w >> 32)); } else { mt[t] = 0.f; m2[t] = 0.f; } ms += mt[t]; }
            const float mean = ms / (float)ntn; float q = 0.f;
#pragma unroll
            for (int t = 0; t < 4; ++t) if (t < ntn) { const float dm = mt[t] - mean; q += m2[t] + 256.0f * dm * dm; }
            S[row] = (f32x2v){mean, 1.0f / sqrtf(q / (256.0f * (float)ntn) + eps)};
        }
        asm volatile("s_waitcnt lgkmcnt(0)" ::: "memory"); __builtin_amdgcn_s_barrier(); asm volatile("" ::: "memory");
        return bad;
    }
};
struct EpiLn1 {
    static constexpr bool PERM = false, AFTER_DRAIN = true;
    const float* xin; float* x1o; bf16_t* xb; const float* gam; const float* bet; PanelStats st; unsigned poison;
    static constexpr float alpha = 1.6817928305074292f;
    __device__ __forceinline__ void fused(f32x4 (&acc)[2][2][4][2], const Unit& u, int wr, int wc, int fr, int fq, PG8_LAS unsigned char* lds, int wid, int lane) const {
        typedef float f32x2v __attribute__((ext_vector_type(2)));
        const PG8_LAS f32x2v* S = (const PG8_LAS f32x2v*)(lds + 8192);
        const int col0 = u.pn * BM + wc * 32 + 4 * fq;
        const unsigned bo0 = (unsigned)((u.pm * BM + wr * 64 + fr) * 1024 + col0) * 4u;
        const char* xinb = (const char*)xin; char* x1b = (char*)x1o; char* xbb = (char*)xb;
#pragma unroll
        for (int ai = 0; ai < 2; ++ai)
#pragma unroll
            for (int m = 0; m < 4; ++m) { const unsigned bo = bo0 + (unsigned)((ai * HALF + m * 16) * 4096);
#pragma unroll
                for (int bj = 0; bj < 2; ++bj)
#pragma unroll
                    for (int n = 0; n < 2; ++n) acc[ai][bj][m][n] += *(const f32x4*)(xinb + bo + (bj * HALF + n * 16) * 4) * alpha;
                asm volatile("" : "+v"(acc[ai][0][m][0]), "+v"(acc[ai][0][m][1]), "+v"(acc[ai][1][m][0]), "+v"(acc[ai][1][m][1]));
                if (m & 1) asm volatile("" ::: "memory"); }
        const bool bad = st.run(acc, u, wr, wc, fr, fq, lds, wid, lane) || poison != 0u;
        const float qnan = __builtin_nanf("");
#pragma unroll
        for (int bj = 0; bj < 2; ++bj)
#pragma unroll
            for (int n = 0; n < 2; ++n) {
                const f32x4 gv = *(const f32x4*)(gam + col0 + bj * HALF + n * 16), bv = *(const f32x4*)(bet + col0 + bj * HALF + n * 16);
#pragma unroll
                for (int ai = 0; ai < 2; ++ai)
#pragma unroll
                    for (int m = 0; m < 4; ++m) { const int r = ai * HALF + wr * 64 + m * 16 + fr; const f32x2v sr = S[r];
                        const unsigned bo = bo0 + (unsigned)((ai * HALF + m * 16) * 4096 + (bj * HALF + n * 16) * 4);
                        f32x4 o = (acc[ai][bj][m][n] - sr.x) * sr.y * gv + bv;
                        if (bad) o = (f32x4){qnan, qnan, qnan, qnan};
                        *(f32x4*)(x1b + bo) = o;
                        u32x2 w; w.x = cvt_pk_bf16(o[0], o[1]); w.y = cvt_pk_bf16(o[2], o[3]); *(u32x2*)(xbb + (bo >> 1)) = w; }
                asm volatile("" ::: "memory"); }
    }
};
struct MoeOrder {
    const int* tile_e; int nunits, G, c;
    __device__ __forceinline__ bool next(int i, Unit& u) const {
        const int L = i * G + c; if (L >= nunits) return false;
        u.pm = L >> 2; u.pn = __builtin_amdgcn_readfirstlane(tile_e[L >> 2]) * 4 + (L & 3); return true;
    }
    __device__ __forceinline__ void a_ready(const Unit&) const {}
    __device__ __forceinline__ void done(const Unit&) const {}
};
template <class Epi, class Sched, bool ALIGN_EPI = false, bool SP2 = false>
__device__ __forceinline__ void gemm_phase(PG8_LAS unsigned char* lds, const Gemm g, const Sched& S, const Epi& E) {
    int tid_ = threadIdx.x; asm volatile("" : "+v"(tid_));
    const int tid = tid_, wid = __builtin_amdgcn_readfirstlane(tid >> 6), lane = tid & 63, wr = wid >> 2, wc = wid & 3, fr = lane & 15, fq = lane >> 4;
    const int K = g.K, nt = K / BK;
    unsigned voffA[2], voffB[2];
#pragma unroll
    for (int i = 0; i < 2; ++i) { int R, C; stage_rc(tid * 16 + i * 8192, R, C); const int Rb = Epi::PERM ? ((R & ~31) + perm32(R & 31)) : R;
        voffA[i] = (unsigned)(R * K + C) * 2u; voffB[i] = (unsigned)(Rb * K + C) * 2u; }
    const size_t kstep = (size_t)(BK * 2);
    const size_t hstep = (size_t)HALF * K * 2;
    const size_t tstep = 2 * hstep;
    const unsigned ldsw = (unsigned)wid * 1024u;
    const int aoff = lds_byte(wr * 64 + fr, fq * 8), boff = lds_byte(wc * 32 + fr, fq * 8);
#define PG8_SA(b, h) (((b) * 2 + (h)) * HTB)
#define PG8_SB(b, h) ((4 + (b) * 2 + (h)) * HTB)
#define PG8_STAGE(bufoff, gbase, voff) do { _Pragma("unroll") for (int _i = 0; _i < 2; ++_i) \
        __builtin_amdgcn_global_load_lds((const unsigned*)((const char*)(gbase) + (voff)[_i]), (PG8_LAS unsigned*)(lds + (bufoff) + ldsw + _i * 8192), 16, 0, 0); } while (0)
#define PG8_LDA(dst, b, h) do { _Pragma("unroll") for (int m = 0; m < 4; ++m) _Pragma("unroll") for (int k = 0; k < 2; ++k) dst[m][k] = *(const PG8_LAS bf16x8*)(lds + PG8_SA(b, h) + aoff + m * 2048 + k * 1024); } while (0)
#define PG8_LDB(dst, b, h) do { _Pragma("unroll") for (int n = 0; n < 2; ++n) _Pragma("unroll") for (int k = 0; k < 2; ++k) dst[n][k] = *(const PG8_LAS bf16x8*)(lds + PG8_SB(b, h) + boff + n * 2048 + k * 1024); } while (0)
#define PG8_MMA(ai, bj, At, Bt) do { __builtin_amdgcn_s_setprio(1); _Pragma("unroll") for (int m = 0; m < 4; ++m) _Pragma("unroll") for (int n = 0; n < 2; ++n) _Pragma("unroll") for (int k = 0; k < 2; ++k) \
        acc[ai][bj][m][n] = __builtin_amdgcn_mfma_f32_16x16x32_bf16(Bt[n][k], At[m][k], acc[ai][bj][m][n], 0, 0, 0); __builtin_amdgcn_s_setprio(0); } while (0)
#define PG8_WAIT_V(n) asm volatile("s_waitcnt vmcnt(" #n ")" ::: "memory")
#define PG8_WAIT_L(n) asm volatile("s_waitcnt lgkmcnt(" #n ")" ::: "memory")
#define PG8_BAR __builtin_amdgcn_s_barrier()
#define PG8_SCHED __builtin_amdgcn_sched_barrier(0)
    Unit cur, nxt; int ui = 0;
    if (!S.next(0, cur)) return;
    f32x4 acc[2][2][4][2];
#pragma unroll
    for (int a = 0; a < 2; ++a)
#pragma unroll
        for (int b = 0; b < 2; ++b)
#pragma unroll
            for (int m = 0; m < 4; ++m)
#pragma unroll
                for (int n = 0; n < 2; ++n) acc[a][b][m][n] = (f32x4){0.f, 0.f, 0.f, 0.f};
    bf16x8 At[4][2], B0[2][2], B1[2][2];
    const char* cA = (const char*)g.A + (size_t)cur.pm * tstep; const char* cB = (const char*)g.Bt + (size_t)cur.pn * tstep;
    S.a_ready(cur);
    if constexpr (SP2) {
        PG8_STAGE(PG8_SB(0, 0), cB, voffB); PG8_STAGE(PG8_SB(0, 1), cB + hstep, voffB); PG8_STAGE(PG8_SA(0, 0), cA, voffA); PG8_STAGE(PG8_SA(0, 1), cA + hstep, voffA);
        if (wr == 1) PG8_BAR;
        PG8_WAIT_V(2); PG8_BAR;
        PG8_STAGE(PG8_SB(1, 0), cB + kstep, voffB); PG8_STAGE(PG8_SA(1, 0), cA + kstep, voffA); PG8_STAGE(PG8_SB(1, 1), cB + hstep + kstep, voffB);
        PG8_WAIT_V(6); PG8_BAR;
    } else {
        PG8_STAGE(PG8_SB(0, 0), cB, voffB); PG8_STAGE(PG8_SA(0, 0), cA, voffA); PG8_STAGE(PG8_SB(0, 1), cB + hstep, voffB); PG8_STAGE(PG8_SA(0, 1), cA + hstep, voffA);
        if (wr == 1) PG8_BAR;
        PG8_WAIT_V(4); PG8_BAR;
        PG8_STAGE(PG8_SB(1, 0), cB + kstep, voffB); PG8_STAGE(PG8_SA(1, 0), cA + kstep, voffA); PG8_STAGE(PG8_SB(1, 1), cB + hstep + kstep, voffB);
        PG8_WAIT_V(6); PG8_BAR;
    }
    for (;;) {
        const bool has_next = S.next(ui + 1, nxt);
        const char* nA = has_next ? (const char*)g.A + (size_t)nxt.pm * tstep : cA; const char* nB = has_next ? (const char*)g.Bt + (size_t)nxt.pn * tstep : cB;
        for (int t = 0; t < nt; t += 2) {
            const bool last = (t == nt - 2);
            const char* a1 = cA + (size_t)(t + 1) * kstep;
            const char* a2 = last ? nA : cA + (size_t)(t + 2) * kstep; const char* b2 = last ? nB : cB + (size_t)(t + 2) * kstep;
            const char* a3 = a2 + kstep; const char* b3 = b2 + kstep;
            if (last && has_next) S.a_ready(nxt);
            if constexpr (SP2) {
            PG8_LDB(B0, 0, 0); PG8_LDB(B1, 0, 1); PG8_SCHED; PG8_LDA(At, 0, 0); PG8_STAGE(PG8_SA(1, 1), a1 + hstep, voffA);
            PG8_WAIT_V(8); PG8_WAIT_L(0); PG8_BAR; PG8_MMA(0, 0, At, B0); PG8_MMA(0, 1, At, B1); PG8_BAR; PG8_SCHED;
            PG8_LDA(At, 0, 1); PG8_STAGE(PG8_SB(0, 0), b2, voffB); PG8_STAGE(PG8_SB(0, 1), b2 + hstep, voffB); PG8_STAGE(PG8_SA(0, 0), a2, voffA);
            PG8_WAIT_V(8); PG8_WAIT_L(0); PG8_BAR; PG8_MMA(1, 0, At, B0); PG8_MMA(1, 1, At, B1); PG8_BAR; PG8_SCHED;
            PG8_LDB(B0, 1, 0); PG8_LDB(B1, 1, 1); PG8_SCHED; PG8_LDA(At, 1, 0); PG8_STAGE(PG8_SA(0, 1), a2 + hstep, voffA);
            PG8_WAIT_V(8); PG8_WAIT_L(0); PG8_BAR; PG8_MMA(0, 0, At, B0); PG8_MMA(0, 1, At, B1); PG8_BAR; PG8_SCHED;
            PG8_LDA(At, 1, 1); PG8_STAGE(PG8_SB(1, 0), b3, voffB); PG8_STAGE(PG8_SB(1, 1), b3 + hstep, voffB); PG8_STAGE(PG8_SA(1, 0), a3, voffA);
            PG8_WAIT_V(8); PG8_WAIT_L(0); PG8_BAR; PG8_MMA(1, 0, At, B0); PG8_MMA(1, 1, At, B1); PG8_BAR; PG8_SCHED;
            } else {
            PG8_LDB(B0, 0, 0); PG8_SCHED; PG8_LDA(At, 0, 0); PG8_STAGE(PG8_SA(1, 1), a1 + hstep, voffA);
            PG8_WAIT_L(8); PG8_BAR; PG8_WAIT_L(0); PG8_MMA(0, 0, At, B0); PG8_BAR; PG8_SCHED;
            PG8_LDB(B1, 0, 1); PG8_STAGE(PG8_SB(0, 0), b2, voffB);
            PG8_BAR; PG8_WAIT_L(0); PG8_MMA(0, 1, At, B1); PG8_BAR;
            PG8_LDA(At, 0, 1); PG8_STAGE(PG8_SA(0, 0), a2, voffA);
            PG8_BAR; PG8_WAIT_L(0); PG8_MMA(1, 0, At, B0); PG8_BAR; PG8_SCHED;
            PG8_STAGE(PG8_SB(0, 1), b2 + hstep, voffB);
            PG8_WAIT_V(6); PG8_BAR; PG8_MMA(1, 1, At, B1); PG8_BAR;
            PG8_LDB(B0, 1, 0); PG8_SCHED; PG8_LDA(At, 1, 0); PG8_STAGE(PG8_SA(0, 1), a2 + hstep, voffA);
            PG8_WAIT_L(8); PG8_BAR; PG8_WAIT_L(0); PG8_MMA(0, 0, At, B0); PG8_BAR; PG8_SCHED;
            PG8_LDB(B1, 1, 1); PG8_STAGE(PG8_SB(1, 0), b3, voffB);
            PG8_BAR; PG8_WAIT_L(0); PG8_MMA(0, 1, At, B1); PG8_BAR;
            PG8_LDA(At, 1, 1); PG8_STAGE(PG8_SA(1, 0), a3, voffA);
            PG8_BAR; PG8_WAIT_L(0); PG8_MMA(1, 0, At, B0); PG8_BAR; PG8_SCHED;
            PG8_STAGE(PG8_SB(1, 1), b3 + hstep, voffB);
            PG8_WAIT_V(6); PG8_BAR; PG8_MMA(1, 1, At, B1); PG8_BAR;
            }
        }
        if constexpr (ALIGN_EPI) { if (wr == 0) PG8_BAR; }
        if constexpr (!Epi::AFTER_DRAIN) { E(acc, cur, wr, wc, fr, fq); S.done(cur); }
        if (!has_next) break;
#pragma unroll
        for (int a = 0; a < 2; ++a)
#pragma unroll
            for (int b = 0; b < 2; ++b)
#pragma unroll
                for (int m = 0; m < 4; ++m)
#pragma unroll
                    for (int n = 0; n < 2; ++n) acc[a][b][m][n] = (f32x4){0.f, 0.f, 0.f, 0.f};
        cur = nxt; cA = nA; cB = nB; ++ui;
        if constexpr (ALIGN_EPI) { if (wr == 1) PG8_BAR; }
    }
    PG8_WAIT_V(0);
    if constexpr (!ALIGN_EPI) { if (wr == 0) PG8_BAR; }
    PG8_BAR;
    if constexpr (Epi::AFTER_DRAIN) { E.fused(acc, cur, wr, wc, fr, fq, lds, wid, lane); S.done(cur); }
#undef PG8_SA
#undef PG8_SB
#undef PG8_STAGE
#undef PG8_LDA
#undef PG8_LDB
#undef PG8_MMA
#undef PG8_WAIT_V
#undef PG8_WAIT_L
#undef PG8_BAR
#undef PG8_SCHED
}
}
namespace attn {
constexpr int D = 128, QS = 1024, KVS = 256, OS = 1024;
constexpr float THR = 8.f;
constexpr bool WSKIP = true;
constexpr float SCALE = 0.08838834764831845f;
constexpr int NW = 8, QBLK = 32, KVBLK = 64, QB = NW * QBLK;
constexpr int SHM_V = KVBLK * D * 2, SHM_K = KVBLK * D * 2;
constexpr int LDS_BYTES = 2 * SHM_V + 2 * SHM_K + NW * 64 * 4;
using bf16 = __hip_bfloat16;
typedef short bf16x8 __attribute__((ext_vector_type(8)));
typedef short s16x4 __attribute__((ext_vector_type(4)));
typedef float f32x16 __attribute__((ext_vector_type(16)));
typedef float f32x4 __attribute__((ext_vector_type(4)));
typedef unsigned u32x4 __attribute__((ext_vector_type(4)));
template <class A, class Bt> struct same_t { static constexpr bool v = false; };
template <class A> struct same_t<A, A> { static constexpr bool v = true; };

#define KSWZ(row, colB) ((row) * 256 + ((colB) ^ (((row) & 7) << 4)))
#define SBAR() __builtin_amdgcn_sched_barrier(0)
__device__ __forceinline__ int v_st(int k, int c) { const int kk = (k & ~0xC) | ((k & 4) << 1) | ((k & 8) >> 1); return ((kk >> 3) * 4 + (c >> 5)) * 512 + ((kk & 7) * 32 + (c & 31)) * 2; }
__device__ __forceinline__ int v_rd_base(int lane) { return ((lane & 3) << 3) | (((lane >> 2) & 3) << 6) | (((lane >> 4) & 1) << 5) | (((lane >> 5) & 1) << 8); }
constexpr int v_rd_off(int d0, int ks, int half) { return d0 * 512 + ks * 4096 + half * 2048; }
__device__ __forceinline__ int crow(int r, int hi) { return (r & 3) + 8 * (r >> 2) + 4 * hi; }
__device__ __forceinline__ unsigned cvtpk(float lo, float hi) {
    unsigned r; asm volatile("v_cvt_pk_bf16_f32 %0, %1, %2" : "=v"(r) : "v"(lo), "v"(hi)); return r;
}
__device__ __forceinline__ bf16x8 pack8(f32x4 a, f32x4 b) {
    u32x4 w = {cvtpk(a[0], a[1]), cvtpk(a[2], a[3]), cvtpk(b[0], b[1]), cvtpk(b[2], b[3])};
    return *reinterpret_cast<bf16x8*>(&w);
}
template <class T> __device__ __forceinline__ bf16x8 load8(const T* p) {
    if constexpr (same_t<T, float>::v) { return pack8(*(const f32x4*)p, *(const f32x4*)(p + 4)); }
    else { return *reinterpret_cast<const bf16x8*>(p); }
}
__device__ __forceinline__ void mask_tile(f32x16& p0, f32x16& p1, int dq, unsigned W) {
    const float NEG = -__builtin_inff();
#pragma unroll
    for (int r = 0; r < 16; ++r) {
        const int c = (r & 3) + 8 * (r >> 2);
        if ((unsigned)(dq - c) >= W) p0[r] = NEG;
        if ((unsigned)(dq - c - 32) >= W) p1[r] = NEG;
    }
}
__device__ __forceinline__ void partialSM(f32x16& p0, f32x16& p1, float& m_reg, float& mn, float& alpha) {
    float pmax = p0[0]; for (int r = 1; r < 16; ++r) pmax = fmaxf(pmax, p0[r]); for (int r = 0; r < 16; ++r) pmax = fmaxf(pmax, p1[r]);
    { auto rr = __builtin_amdgcn_permlane32_swap(__float_as_uint(pmax), __float_as_uint(pmax), false, false);
      pmax = fmaxf(__uint_as_float(rr[0]), __uint_as_float(rr[1])); }
    constexpr float C2 = 1.4426950408889634f * SCALE;
    if (__builtin_expect(__all((pmax - m_reg) * SCALE <= THR), 1)) { mn = m_reg; alpha = 1.f; }
    else { mn = fmaxf(m_reg, pmax); alpha = __builtin_amdgcn_exp2f((m_reg - mn) * C2); m_reg = mn; }
    const float mnL = -mn * C2;
    for (int r = 0; r < 16; ++r) p0[r] = fmaf(p0[r], C2, mnL); for (int r = 0; r < 16; ++r) p1[r] = fmaf(p1[r], C2, mnL);
    for (int r = 0; r < 16; ++r) p0[r] = __builtin_amdgcn_exp2f(p0[r]);
}
__device__ __forceinline__ void finishSM(f32x16& p0, f32x16& p1, float alpha, float& l_reg, bf16x8& pa0, bf16x8& pa1, bf16x8& pa2, bf16x8& pa3) {
    for (int r = 0; r < 16; ++r) p1[r] = __builtin_amdgcn_exp2f(p1[r]);
    float ps = 0; for (int r = 0; r < 16; ++r) ps += p0[r]; for (int r = 0; r < 16; ++r) ps += p1[r];
    { auto rr = __builtin_amdgcn_permlane32_swap(__float_as_uint(ps), __float_as_uint(ps), false, false);
      ps = __uint_as_float(rr[0]) + __uint_as_float(rr[1]); }
    l_reg = l_reg * alpha + ps;
#define PK4(P, B_, OUT) do { unsigned a0 = cvtpk(P[B_+0], P[B_+1]), a1 = cvtpk(P[B_+2], P[B_+3]);                          \
        unsigned b0 = cvtpk(P[B_+4], P[B_+5]), b1 = cvtpk(P[B_+6], P[B_+7]);                                             \
        auto r0 = __builtin_amdgcn_permlane32_swap(a0, b0, false, false); auto r1 = __builtin_amdgcn_permlane32_swap(a1, b1, false, false); \
        u32x4 w = {r0[0], r1[0], r0[1], r1[1]}; OUT = *reinterpret_cast<bf16x8*>(&w); } while (0)
    PK4(p0, 0, pa0); PK4(p0, 8, pa1); PK4(p1, 0, pa2); PK4(p1, 8, pa3);
#undef PK4
}
template <int KB, bool SK>
__device__ __forceinline__ void qkt(f32x16& p0, f32x16& p1, const char* K_lds, int r32, int hi, const bf16x8* qr, bool act) {
    if (SK && !act) { const float NEG = -__builtin_inff();
#pragma unroll
        for (int r = 0; r < 16; ++r) { p0[r] = NEG; p1[r] = NEG; } return; }
    p0 = f32x16{}; p1 = f32x16{};
    const char* kb[4];
#pragma unroll
    for (int dd = 0; dd < 4; ++dd) kb[dd] = K_lds + KB * SHM_K + KSWZ(r32, (dd * 16 + hi * 8) * 2);
#pragma unroll
    for (int d0 = 0; d0 < 8; ++d0) { const char* a = kb[d0 & 3] + (d0 >> 2) * 128;
        bf16x8 b0 = *reinterpret_cast<const bf16x8*>(a);
        bf16x8 b1 = *reinterpret_cast<const bf16x8*>(a + 32 * 256);
        p0 = __builtin_amdgcn_mfma_f32_32x32x16_bf16(b0, qr[d0], p0, 0, 0, 0);
        p1 = __builtin_amdgcn_mfma_f32_32x32x16_bf16(b1, qr[d0], p1, 0, 0, 0); }
}
template <int VB, bool SK>
__device__ __forceinline__ void pv_tile(f32x16* o, int vb0, bf16x8 pa0, bf16x8 pa1, bf16x8 pa2, bf16x8 pa3, bool act) {
    if (SK && !act) return;
#define TRRD(dst, off) asm volatile("ds_read_b64_tr_b16 %0, %1 offset:%2" : "=&v"(dst) : "v"(vb0), "i"(off) : "memory")
#define PV_D0(d0) do { s16x4 l0, l1, l2, l3, h0, h1, h2, h3; constexpr int b_ = VB * SHM_V + v_rd_off(d0, 0, 0);     \
        TRRD(l0, b_); TRRD(h0, b_ + 2048); TRRD(l1, b_ + 4096); TRRD(h1, b_ + 6144); TRRD(l2, b_ + 8192); TRRD(h2, b_ + 10240); TRRD(l3, b_ + 12288); TRRD(h3, b_ + 14336); \
        asm volatile("s_waitcnt lgkmcnt(0)" ::: "memory"); SBAR();                 \
        o[d0] = __builtin_amdgcn_mfma_f32_32x32x16_bf16(pa0, (bf16x8){l0[0], l0[1], l0[2], l0[3], h0[0], h0[1], h0[2], h0[3]}, o[d0], 0, 0, 0);   \
        o[d0] = __builtin_amdgcn_mfma_f32_32x32x16_bf16(pa1, (bf16x8){l1[0], l1[1], l1[2], l1[3], h1[0], h1[1], h1[2], h1[3]}, o[d0], 0, 0, 0);   \
        o[d0] = __builtin_amdgcn_mfma_f32_32x32x16_bf16(pa2, (bf16x8){l2[0], l2[1], l2[2], l2[3], h2[0], h2[1], h2[2], h2[3]}, o[d0], 0, 0, 0);   \
        o[d0] = __builtin_amdgcn_mfma_f32_32x32x16_bf16(pa3, (bf16x8){l3[0], l3[1], l3[2], l3[3], h3[0], h3[1], h3[2], h3[3]}, o[d0], 0, 0, 0); } while (0)
    PV_D0(0); PV_D0(1); PV_D0(2); PV_D0(3);
#undef PV_D0
#undef TRRD
}

template <class TIn, class TOut> struct BlockRef { const TIn* Q; const TIn* K; const TIn* V; TOut* O; int P0; float sinkl2; };
template <class TIn> struct Seam {
    bf16x8 qr[8];
    bf16x8 st_v0, st_v1, st_k0, st_k1; f32x4 sf0, sf1, sf2, sf3;
    f32x4 tq[16];
};
__device__ __forceinline__ int swa_jlo(int P0, int W) { const int lowk = P0 - W; return lowk > 0 ? lowk / KVBLK : 0; }
#define ROW(p, k0, rr) ((p) + (size_t)((k0) + (rr)) * KVS + sc)
#define VMW() asm volatile("s_waitcnt vmcnt(0)" ::: "memory")
#define VMWN(n) asm volatile("s_waitcnt vmcnt(%0)" :: "i"(n) : "memory")
#define SLOAD_H(Kp, Vp, k0) do { S.st_v0 = load8<TIn>(ROW(Vp, k0, sr)); S.st_v1 = load8<TIn>(ROW(Vp, k0, 32 + sr));              \
                         S.st_k0 = load8<TIn>(ROW(Kp, k0, sr)); S.st_k1 = load8<TIn>(ROW(Kp, k0, 32 + sr)); } while (0)
#define SWRITE_HK(bf) do { *(bf16x8*)(K_lds + (bf) * SHM_K + kws) = S.st_k0; *(bf16x8*)(K_lds + (bf) * SHM_K + kws + 32 * 256) = S.st_k1; } while (0)
#define SWRITE_HV(bf) do { *(bf16x8*)(V_lds + (bf) * SHM_V + vst0) = S.st_v0; *(bf16x8*)(V_lds + (bf) * SHM_V + vst1) = S.st_v1; } while (0)
#define SWRITE_H(bf) do { SWRITE_HV(bf); SWRITE_HK(bf); } while (0)
#define SLOAD_F(p, k0) do { S.sf0 = *(const f32x4*)ROW(p, k0, sr); S.sf1 = *(const f32x4*)(ROW(p, k0, sr) + 4);                \
                            S.sf2 = *(const f32x4*)ROW(p, k0, 32 + sr); S.sf3 = *(const f32x4*)(ROW(p, k0, 32 + sr) + 4); } while (0)
#define SWRITE_KF(bf) do { *(bf16x8*)(K_lds + (bf) * SHM_K + kws) = pack8(S.sf0, S.sf1); *(bf16x8*)(K_lds + (bf) * SHM_K + kws + 32 * 256) = pack8(S.sf2, S.sf3); } while (0)
#define SWRITE_VF(bf) do { *(bf16x8*)(V_lds + (bf) * SHM_V + vst0) = pack8(S.sf0, S.sf1); *(bf16x8*)(V_lds + (bf) * SHM_V + vst1) = pack8(S.sf2, S.sf3); } while (0)
template <class TIn, class TOut>
__device__ __forceinline__ void causal_swa_prime(const BlockRef<TIn, TOut>& cur, int W, char* lds, Seam<TIn>& S) {
    constexpr bool F32 = same_t<TIn, float>::v;
    int tid_ = threadIdx.x; asm volatile("" : "+v"(tid_));
    const int tid = tid_, wid = __builtin_amdgcn_readfirstlane(tid >> 6), lane = tid & 63, r32 = lane & 31, hi = lane >> 5;
    const int sr = tid >> 4, sc = (tid & 15) * 8, kws = KSWZ(sr, sc * 2); char* K_lds = lds + 2 * SHM_V;
    const int kb0 = swa_jlo(cur.P0, W) * KVBLK;
    for (int d0 = 0; d0 < 8; ++d0) S.qr[d0] = load8<TIn>(cur.Q + (size_t)(wid * QBLK + r32) * QS + d0 * 16 + hi * 8);
    if constexpr (F32) { SLOAD_F((const float*)cur.K, kb0); VMW(); SWRITE_KF(0); SBAR(); SLOAD_F((const float*)cur.V, kb0); }
    else { SLOAD_H(cur.K, cur.V, kb0); VMW(); SWRITE_HK(0); }
    __syncthreads();
}
template <class TIn, class TOut>
__device__ __forceinline__ void causal_swa_block(const BlockRef<TIn, TOut>& cur, const BlockRef<TIn, TOut>& nxt, int skv, int W, char* lds, Seam<TIn>& S) {
    constexpr bool F32 = same_t<TIn, float>::v;
    int tid_ = threadIdx.x; asm volatile("" : "+v"(tid_));
    const int tid = tid_, wid = __builtin_amdgcn_readfirstlane(tid >> 6), lane = tid & 63, r32 = lane & 31, hi = lane >> 5;
    const int j_lo = swa_jlo(cur.P0, W);
    int j_hi = (cur.P0 + QB - 1 + W) / KVBLK + 1; if (j_hi > skv / KVBLK) j_hi = skv / KVBLK;
    const int NT = j_hi - j_lo;
    const int kbn = swa_jlo(nxt.P0, W) * KVBLK;
    const int qlo = cur.P0 + wid * QBLK, qm = qlo + r32 - 4 * hi;
    char* V_lds = lds; char* K_lds = lds + 2 * SHM_V;
    float* ws = (float*)(lds + 2 * SHM_V + 2 * SHM_K) + wid * 64; float* li_l = ws, * al_l = ws + 32;
    float m_reg = -1e30f, l_reg = 0; f32x16 o[4] = {};
    const int sr = tid >> 4, sc = (tid & 15) * 8, vst0 = v_st(sr, sc), vst1 = v_st(32 + sr, sc), kws = KSWZ(sr, sc * 2);
    const int vb0 = (int)(uintptr_t)V_lds + v_rd_base(lane);
    const TIn* Kh = cur.K; const TIn* Vh = cur.V;
#define RESC(a) do { if (__any((a) < 1.f)) { if (hi == 0) al_l[r32] = (a); asm volatile("s_waitcnt lgkmcnt(0)" ::: "memory");              \
                     for (int d_ = 0; d_ < 4; ++d_) for (int r = 0; r < 16; ++r) o[d_][r] *= al_l[crow(r, hi)]; } } while (0)
#define KBASE(t) ((j_lo + (t)) * KVBLK)
#define ACT(t) (KBASE(t) <= qlo + QBLK - 1 + W && KBASE(t) + KVBLK - 1 >= qlo - W)
#define MASKT(P0_, P1_, t) do { const int kb_ = KBASE(t); if ((!SK || ACT(t)) && (kb_ + KVBLK - 1 > qlo + W || kb_ < qlo + QBLK - 1 - W)) mask_tile(P0_, P1_, qm - kb_ + W, (unsigned)(2 * W + 1)); } while (0)
    constexpr int NQL = F32 ? 16 : 8;
    constexpr bool SK = WSKIP && !F32;
#define SEAM_K0() do { VMWN(NQL); if constexpr (F32) { SWRITE_KF(0); SBAR(); SLOAD_F((const float*)nxt.V, kbn); } else { SWRITE_HK(0); } SBAR(); } while (0)
    f32x16 pA0, pA1, pB0, pB1; float mnA, mnB, alA, alB; bf16x8 pa0, pa1, pa2, pa3;
    if constexpr (F32) { VMW(); SWRITE_VF(0); SBAR(); } else { SWRITE_HV(0); SBAR(); }
    if (NT > 1) { if constexpr (F32) SLOAD_F((const float*)Kh, KBASE(1)); else SLOAD_H(Kh, Vh, KBASE(1)); }
    SBAR(); qkt<0, SK>(pA0, pA1, K_lds, r32, hi, S.qr, ACT(0));
    if constexpr (F32) { if (NT > 1) { VMW(); SWRITE_KF(1); SBAR(); SLOAD_F((const float*)Vh, KBASE(1)); } }
    MASKT(pA0, pA1, 0); partialSM(pA0, pA1, m_reg, mnA, alA);
    if (NT > 1) { VMW(); if constexpr (F32) { SWRITE_VF(1); SBAR(); if (NT > 2) SLOAD_F((const float*)Kh, KBASE(2)); } else SWRITE_H(1); }
    __syncthreads();
#define HALF_STEP(PX0, PX1, mnX, alX, PY0, PY1, alY, t, KB, VB, SB) do {                                                      \
        SBAR(); qkt<KB, SK>(PX0, PX1, K_lds, r32, hi, S.qr, ACT(t));                                             \
        finishSM(PY0, PY1, alY, l_reg, pa0, pa1, pa2, pa3); SBAR();                                                           \
        if ((t) + 1 < NT) { if constexpr (F32) { VMW(); SWRITE_KF(SB); SBAR(); SLOAD_F((const float*)Vh, KBASE((t) + 1)); }  \
                            else { SLOAD_H(Kh, Vh, KBASE((t) + 1)); } SBAR(); }                                               \
        pv_tile<VB, SK>(o, vb0, pa0, pa1, pa2, pa3, ACT((t) - 1)); MASKT(PX0, PX1, (t)); partialSM(PX0, PX1, m_reg, mnX, alX);                                        \
        __syncthreads();                                                                                                      \
        if ((t) + 1 < NT) { VMW(); if constexpr (F32) { SWRITE_VF(SB); SBAR(); if ((t) + 2 < NT) SLOAD_F((const float*)Kh, KBASE((t) + 2)); } \
                            else { SWRITE_H(SB); } }                                                                          \
        RESC(alX); __syncthreads(); } while (0)
    for (int t = 1; t + 1 < NT; t += 2) {
        HALF_STEP(pB0, pB1, mnB, alB, pA0, pA1, alA, t, 1, 0, 0);
        HALF_STEP(pA0, pA1, mnA, alA, pB0, pB1, alB, t + 1, 0, 1, 1);
    }
    const bool even = (NT & 1) == 0;
    if (even) { SBAR(); qkt<1, SK>(pB0, pB1, K_lds, r32, hi, S.qr, ACT(NT - 1)); SBAR(); }
#define QROW(e) (nxt.Q + (size_t)(wid * QBLK + r32) * QS + ((e) >> 1) * 16 + hi * 8 + ((e) & 1) * 4)
    if constexpr (F32) { SLOAD_F((const float*)nxt.K, kbn); SBAR();
#pragma unroll
        for (int e = 0; e < 8; ++e) S.tq[e] = *(const f32x4*)QROW(e); }
    else { SLOAD_H(nxt.K, nxt.V, kbn); SBAR();
#pragma unroll
        for (int d0 = 0; d0 < 8; ++d0) S.qr[d0] = load8<TIn>(nxt.Q + (size_t)(wid * QBLK + r32) * QS + d0 * 16 + hi * 8); }
    SBAR();
    finishSM(pA0, pA1, alA, l_reg, pa0, pa1, pa2, pa3); SBAR();
    if constexpr (F32) {
#pragma unroll
        for (int e = 8; e < 16; ++e) S.tq[e] = *(const f32x4*)QROW(e); SBAR(); }
#undef QROW
    pv_tile<0, SK>(o, vb0, pa0, pa1, pa2, pa3, ACT(even ? NT - 2 : NT - 1));
    if (even) { MASKT(pB0, pB1, NT - 1); partialSM(pB0, pB1, m_reg, mnB, alB); __syncthreads(); RESC(alB);
        finishSM(pB0, pB1, alB, l_reg, pa0, pa1, pa2, pa3); SBAR(); pv_tile<1, SK>(o, vb0, pa0, pa1, pa2, pa3, ACT(NT - 1)); }
    SBAR(); SEAM_K0();
    l_reg += __builtin_amdgcn_exp2f(cur.sinkl2 - m_reg * (1.4426950408889634f * SCALE));
    if (hi == 0) li_l[r32] = l_reg; asm volatile("s_waitcnt lgkmcnt(0)" ::: "memory");
    float rli[16];
#pragma unroll
    for (int r = 0; r < 16; ++r) rli[r] = __builtin_amdgcn_rcpf(li_l[crow(r, hi)]);
    TOut* Ow = cur.O + (size_t)(wid * QBLK) * OS;
#pragma unroll
    for (int r = 0; r < 16; ++r) { const int orow = crow(r, hi);
#pragma unroll
        for (int d0 = 0; d0 < 4; ++d0) { const float v = o[d0][r] * rli[r];
            if constexpr (same_t<TOut, float>::v) { Ow[(size_t)orow * OS + d0 * 32 + r32] = v; }
            else { const float vn = bperm_f(lane ^ 1, v);
                   if ((r32 & 1) == 0) *(unsigned*)(Ow + (size_t)orow * OS + d0 * 32 + r32) = cvtpk(v, vn); } } }
    if constexpr (F32) {
#pragma unroll
        for (int d0 = 0; d0 < 8; ++d0) S.qr[d0] = pack8(S.tq[2 * d0], S.tq[2 * d0 + 1]); }
    __syncthreads();
#undef RESC
#undef KBASE
#undef ACT
#undef MASKT
#undef SEAM_K0
#undef HALF_STEP
}
#undef ROW
#undef VMW
#undef VMWN
#undef SLOAD_H
#undef SWRITE_HK
#undef SWRITE_HV
#undef SWRITE_H
#undef SLOAD_F
#undef SWRITE_KF
#undef SWRITE_VF


}
#undef KSWZ
#undef SBAR

constexpr int NWAVES = 8, NTHREADS = NWAVES * 64;
constexpr size_t MiB = 1u << 20;
constexpr size_t WS_CTL = 0, CTL_ZERO_BYTES = 1 * MiB;
constexpr size_t WS_WIN = 2 * MiB;
constexpr size_t WS_WAO = 46 * MiB, WS_WRO = 54 * MiB, WS_WOUT = 62 * MiB;
constexpr size_t WS_WG = 70 * MiB;
constexpr size_t WS_WR = 74 * MiB;
constexpr size_t WS_RCOS = 75 * MiB, WS_RSIN = 77 * MiB;
constexpr size_t WS_SP = 79 * MiB;
constexpr size_t WS_ROUTE = 80 * MiB;
constexpr size_t WS_SUMM = 82 * MiB;
constexpr size_t WS_XBUF = 86 * MiB;
constexpr size_t WS_WGU = 96 * MiB;
constexpr size_t WS_WD = 352 * MiB;
constexpr size_t WS_XB = 480 * MiB;
constexpr size_t WS_X1 = 512 * MiB;
constexpr size_t WS_XRES = 576 * MiB;
constexpr size_t WS_Q = 640 * MiB, WS_K = 672 * MiB, WS_V = 680 * MiB, WS_XR = 688 * MiB, WS_YG = 720 * MiB, WS_GA = 752 * MiB, WS_GR = 784 * MiB;
constexpr size_t WS_AO = 816 * MiB, WS_HG = 848 * MiB, WS_YA = 880 * MiB, WS_MG = 912 * MiB, WS_END = 944 * MiB;
constexpr size_t WS_XS = 640 * MiB;
constexpr size_t WS_HID = 720 * MiB;
constexpr size_t WS_YB = 760 * MiB;
constexpr size_t RT_TOKE = 0, RT_TOKPOS = 131072, RT_TOKW = 262144, RT_SLOT = 393216, RT_ROWW = 557056, RT_TILEE = 720896, RT_BLKCNT = 786432;
constexpr int CW_BAR = 4096;
constexpr int CW_CNT = 16384;
constexpr int CW_SEAM = 32768;

constexpr int LDS_BYTES = 147456;

#define GAS __attribute__((address_space(1)))
#define LAS __attribute__((address_space(3)))
typedef unsigned short bf16raw;
typedef unsigned v4u __attribute__((ext_vector_type(4)));
typedef unsigned v2u __attribute__((ext_vector_type(2)));
typedef float f32x4 __attribute__((ext_vector_type(4)));
typedef float f32x2 __attribute__((ext_vector_type(2)));
typedef short bf16x8 __attribute__((ext_vector_type(8)));
#define LDS_WAIT() asm volatile("s_waitcnt lgkmcnt(0)" ::: "memory")
__device__ __forceinline__ unsigned f2bf(float f) { unsigned u = __builtin_bit_cast(unsigned, f); return (u + 0x7fffu + ((u >> 16) & 1u)) >> 16; }
__device__ __forceinline__ unsigned pk2(float lo, float hi) { return f2bf(lo) | (f2bf(hi) << 16); }
__device__ __forceinline__ float bflo(unsigned w) { return __builtin_bit_cast(float, w << 16); }
__device__ __forceinline__ float bfhi(unsigned w) { return __builtin_bit_cast(float, w & 0xffff0000u); }
template <int CTRL, int ROWMASK> __device__ __forceinline__ float dpp_f(float v) { return __builtin_bit_cast(float, __builtin_amdgcn_update_dpp(0, __builtin_bit_cast(int, v), CTRL, ROWMASK, 0xF, false)); }
__device__ __forceinline__ float wave_sum(float v) {
    v += dpp_f<0xB1, 0xF>(v);
    v += dpp_f<0x4E, 0xF>(v);
    v += dpp_f<0x141, 0xF>(v);
    v += dpp_f<0x140, 0xF>(v);
    v += dpp_f<0x142, 0xA>(v);
    v += dpp_f<0x143, 0xC>(v);
    return __builtin_bit_cast(float, __builtin_amdgcn_readlane(__builtin_bit_cast(int, v), 63));
}

#define XB_TMO      128
#define XB_XCNT(j)  (256  + 64 * (j))
#define XB_XSUB(j)  (1280 + 64 * (j))
#define XB_XGEN(j)  (2304 + 64 * (j))
#define XB_TOP      3328
#define XB_TOPGEN   3392
#define XCD_BAR_WORDS 3456
#define XB_SPIN_CAP (1u << 18)

__device__ __forceinline__ unsigned xb_ld(unsigned* p)              { return __hip_atomic_load(p, __ATOMIC_RELAXED, __HIP_MEMORY_SCOPE_AGENT); }
__device__ __forceinline__ unsigned xb_add(unsigned* p, unsigned v) { return __hip_atomic_fetch_add(p, v, __ATOMIC_RELAXED, __HIP_MEMORY_SCOPE_AGENT); }
__device__ __forceinline__ unsigned xb_xcc_id() { return (unsigned)__builtin_amdgcn_s_getreg((3 << 11) | 20) & 0xFu; }
#define XB_SPIN(cond, bar) do { unsigned _sp = 0; while (cond) { __builtin_amdgcn_s_sleep(1); \
    if ((++_sp & 255u) == 0u) { if (xb_ld(&(bar)[XB_TMO])) break; if (_sp > XB_SPIN_CAP) { atomicAdd(&(bar)[XB_TMO], 1u); break; } } } } while (0)

struct XcdBarrier {
    unsigned* bar; unsigned x;
    volatile LAS unsigned* st;
};

__device__ __forceinline__ XcdBarrier xcd_barrier_post(unsigned* bar, volatile LAS unsigned* st) {
    XcdBarrier b; b.bar = bar; b.x = xb_xcc_id(); b.st = st;
    if (threadIdx.x == 0) (void)xb_add(&bar[XB_XCNT(b.x)], 1u);
    return b;
}
__device__ __forceinline__ void xcd_barrier_complete(unsigned* bar, unsigned x, unsigned& nloc, unsigned& nx) {
    const unsigned G = gridDim.x * gridDim.y * gridDim.z;
    unsigned sum, cnt, mine, sp = 0u;
    for (;;) {
        sum = 0u; cnt = 0u; mine = 0u;
#pragma unroll
        for (unsigned j = 0; j < 16; ++j) { const unsigned c = xb_ld(&bar[XB_XCNT(j)]); sum += c; cnt += (c > 0u) ? 1u : 0u; mine = (j == x) ? c : mine; }
        if (sum == G) break;
        __builtin_amdgcn_s_sleep(1);
        if ((++sp & 255u) == 0u) { if (xb_ld(&bar[XB_TMO])) break; if (sp > XB_SPIN_CAP) { atomicAdd(&bar[XB_TMO], 1u); break; } }
    }
    nloc = mine > 0u ? mine : 1u; nx = cnt > 0u ? cnt : 1u;
}

__device__ __forceinline__ void xcd_barrier(const XcdBarrier& b) {
    asm volatile("s_waitcnt vmcnt(0)" ::: "memory");
    __syncthreads();
    if (threadIdx.x == 0) {
        unsigned* bar = b.bar;
        __builtin_amdgcn_s_waitcnt(0);
        unsigned nloc = b.st[0], nx = b.st[1];
        if (nloc == 0u) { xcd_barrier_complete(bar, b.x, nloc, nx); b.st[0] = nloc; b.st[1] = nx; }
        const unsigned old = xb_add(&bar[XB_XSUB(b.x)], 1u);
        const unsigned gen = old / nloc;
        if (old + 1u == (gen + 1u) * nloc) {
            __builtin_amdgcn_fence(__ATOMIC_RELEASE, "agent");
            asm volatile("s_waitcnt vmcnt(0)" ::: "memory");
            const unsigned og = xb_add(&bar[XB_TOP], 1u);
            const unsigned tg = og / nx;
            if (og + 1u == (tg + 1u) * nx) xb_add(&bar[XB_TOPGEN], 1u);
            else XB_SPIN(xb_ld(&bar[XB_TOPGEN]) == tg, bar);
            __builtin_amdgcn_fence(__ATOMIC_ACQUIRE, "agent");
            xb_add(&bar[XB_XGEN(b.x)], 1u);
            asm volatile("s_waitcnt vmcnt(0)" ::: "memory");
        } else {
            XB_SPIN(xb_ld(&bar[XB_XGEN(b.x)]) == gen, bar);
            __builtin_amdgcn_fence(__ATOMIC_ACQUIRE, "agent");
            asm volatile("s_waitcnt vmcnt(0)" ::: "memory");
        }
    }
    __syncthreads();
}
template <int MAP> __device__ __forceinline__ int dest_row(int n, int aux) {
    if (MAP == 1) { if (n >= 1280) return n; const int hb = n & ~127, d = n & 127, dd = d & 63; return hb + 32 * (dd >> 4) + 8 * ((dd >> 2) & 3) + 4 * (d >> 6) + (dd & 3); }
    if (MAP == 2) return 256 * (n >> 7) + 128 * aux + (n & 127);
    return n;
}
struct TItem { const float* W; bf16raw* WT; int K, N, map, aux, k0, n0; float scale; };
__device__ __forceinline__ int dest_row_rt(int map, int n, int aux) { return map == 1 ? dest_row<1>(n, aux) : (map == 2 ? dest_row<2>(n, aux) : n); }
__device__ __forceinline__ void titem_load(const TItem& I, float (&t)[32], int lane) {
#pragma unroll
    for (int i = 0; i < 32; ++i) { const int kk = 2 * i + (lane >> 5); t[i] = __builtin_nontemporal_load(I.W + (size_t)(I.k0 + kk) * I.N + I.n0 + (lane & 31)); }
}
__device__ __forceinline__ void titem_store(const TItem& I, const float (&t)[32], LAS float* scr, int lane) {
#pragma unroll
    for (int i = 0; i < 32; ++i) { const int kk = 2 * i + (lane >> 5); scr[kk * 33 + (lane & 31)] = t[i] * I.scale; }
    LDS_WAIT(); asm volatile("" ::: "memory");
    const int c = lane & 7;
#pragma unroll
    for (int j = 0; j < 4; ++j) { const int n = (lane >> 3) + 8 * j; const LAS float* s = scr + (8 * c) * 33 + n;
        v4u o; o.x = pk2(s[0 * 33], s[1 * 33]); o.y = pk2(s[2 * 33], s[3 * 33]); o.z = pk2(s[4 * 33], s[5 * 33]); o.w = pk2(s[6 * 33], s[7 * 33]);
        *(v4u*)(I.WT + (size_t)dest_row_rt(I.map, I.n0 + n, I.aux) * I.K + I.k0 + 8 * c) = o; }
    LDS_WAIT(); asm volatile("" ::: "memory");
}
struct Ptrs {
    const float* in[22]; float* out; unsigned char* ws;
};
constexpr int PI_IN = 16 * (NIN / 32), PI_SQ = 16 * 32, PI_G = 2 * 4, PI_E = 16 * 16;
constexpr int PN_IN = DEPTH * PI_IN, PN_SQ = DEPTH * PI_SQ, PN_G = DEPTH * 16 * PI_G, PN_E = DEPTH * NEXP * PI_E;
constexpr int P_NITEMS = PN_IN + 3 * PN_SQ + 2 * PN_G + 3 * PN_E;
struct TSrc { const float *w_in, *w_rec, *w_ing, *w_ao, *w_ro, *w_out, *w_eg, *w_eu, *w_ed; unsigned char* ws; };
__device__ __forceinline__ TItem titem_decode(const TSrc& P, int it) {
    TItem I; I.map = 0; I.aux = 0; I.scale = 1.f; int r = it, item;
    if (r < PN_IN) { const int l = r / PI_IN; I.W = P.w_in + (size_t)l * DM * NIN; I.K = DM; I.N = NIN; I.WT = (bf16raw*)(P.ws + WS_WIN) + (size_t)l * NIN * DM; I.map = 1; item = r % PI_IN; }
    else if ((r -= PN_IN) < PN_SQ) { const int l = r / PI_SQ; I.W = P.w_ao + (size_t)l * DM * DM; I.K = DM; I.N = DM; I.WT = (bf16raw*)(P.ws + WS_WAO) + (size_t)l * DM * DM; item = r % PI_SQ; }
    else if ((r -= PN_SQ) < PN_SQ) { const int l = r / PI_SQ; I.W = P.w_ro + (size_t)l * DM * DM; I.K = DM; I.N = DM; I.WT = (bf16raw*)(P.ws + WS_WRO) + (size_t)l * DM * DM; item = r % PI_SQ; }
    else if ((r -= PN_SQ) < PN_SQ) { const int l = r / PI_SQ; I.W = P.w_out + (size_t)l * DM * DM; I.K = DM; I.N = DM; I.WT = (bf16raw*)(P.ws + WS_WOUT) + (size_t)l * DM * DM; item = r % PI_SQ; }
    else if ((r -= PN_SQ) < 2 * PN_G) { const int gate = r >= PN_G ? 1 : 0; r -= gate * PN_G; const int mat = r / PI_G;
        const int l = mat >> 4, dir = (mat >> 3) & 1, n = mat & 7;
        if (gate) I.W = P.w_ing + (size_t)mat * 16384; else I.W = P.w_rec + (size_t)mat * 16384;
        I.K = 128; I.N = 128; I.WT = (bf16raw*)(P.ws + WS_WG) + ((size_t)((l * 2 + dir) * 2 + gate) * 8 + n) * 16384; I.scale = -1.4426950408889634f; item = r % PI_G; }
    else if ((r -= 2 * PN_G) < PN_E) { const int le = r / PI_E; I.W = P.w_eg + (size_t)le * DM * DEXP; I.K = DM; I.N = DEXP; I.WT = (bf16raw*)(P.ws + WS_WGU) + (size_t)le * 1024 * DM; I.map = 2; I.aux = 0; item = r % PI_E; }
    else if ((r -= PN_E) < PN_E) { const int le = r / PI_E; I.W = P.w_eu + (size_t)le * DM * DEXP; I.K = DM; I.N = DEXP; I.WT = (bf16raw*)(P.ws + WS_WGU) + (size_t)le * 1024 * DM; I.map = 2; I.aux = 1; item = r % PI_E; }
    else { r -= PN_E; const int le = r / PI_E; I.W = P.w_ed + (size_t)le * DEXP * DM; I.K = DEXP; I.N = DM; I.WT = (bf16raw*)(P.ws + WS_WD) + (size_t)le * DM * DEXP; item = r % PI_E; }
    const int nblk = I.N / 32; I.k0 = 64 * (item / nblk); I.n0 = 32 * (item % nblk);
    return I;
}
__device__ __forceinline__ void p0_prologue(const Ptrs& P, LAS unsigned char* lds, int vcu, int G, int wave, int lane) {
    LAS float* scr = (LAS float*)(lds + wave * 16384);
    const int gw = vcu * NWAVES + wave, NGW = G * NWAVES;
    {
        const TSrc TS{P.in[1], P.in[5], P.in[7], P.in[10], P.in[11], P.in[12], P.in[19], P.in[20], P.in[21], P.ws};
        int it = gw;
        if (it < P_NITEMS) {
            TItem cur = titem_decode(TS, it); float t[32]; titem_load(cur, t, lane);
#pragma unroll 1
            for (;;) {
                const int itn = it + NGW; const bool more = itn < P_NITEMS;
                const TItem nxt = titem_decode(TS, more ? itn : it); float tn[32];
                titem_load(nxt, tn, lane);
                titem_store(cur, t, scr, lane);
                if (!more) break;
                cur = nxt; it = itn;
#pragma unroll
                for (int i = 0; i < 32; ++i) t[i] = tn[i];
            }
        }
    }
    const int gt = gw * 64 + lane, NGT = NGW * 64;
    float* rc = (float*)(P.ws + WS_RCOS); float* rs = (float*)(P.ws + WS_RSIN);
    for (int i = gt; i < SEQ * 64; i += NGT) { const int t = i >> 6, f = i & 63;
        const float inv = (float)pow(10000.0, -(double)f / 64.0); const float ang = (float)t * inv;
        rc[i] = (float)cos((double)ang); rs[i] = (float)sin((double)ang); }
    float* sp = (float*)(P.ws + WS_SP);
    for (int i = gt; i < DEPTH * 2 * 1024; i += NGT) { const double lam = (double)P.in[9][i]; sp[i] = (float)(8.0 * log1p(exp(-lam))); }
    bf16raw* wrh = (bf16raw*)(P.ws + WS_WR); bf16raw* wrl = wrh + (size_t)DEPTH * 48 * 1024;
    for (int i = gt; i < DEPTH * 48 * 1024; i += NGT) { const int l = i / (48 * 1024), o = (i / 1024) % 48, k = i & 1023;
        const float w = o < 4 ? P.in[15][((size_t)l * 1024 + k) * 4 + o] : (o < 36 ? P.in[17][((size_t)l * 1024 + k) * 32 + (o - 4)] : 0.f);
        const unsigned h = f2bf(w); wrh[i] = (bf16raw)h; wrl[i] = (bf16raw)f2bf(w - __builtin_bit_cast(float, h << 16)); }
    bf16raw* XB = (bf16raw*)(P.ws + WS_XB);
    for (int i = gt; i < TOK * DM / 8; i += NGT) { const f32x4 a = *(const f32x4*)(P.in[0] + (size_t)i * 8), b = *(const f32x4*)(P.in[0] + (size_t)i * 8 + 4);
        v4u o; o.x = pk2(a[0], a[1]); o.y = pk2(a[2], a[3]); o.z = pk2(b[0], b[1]); o.w = pk2(b[2], b[3]); *(v4u*)(XB + (size_t)i * 8) = o; }
}

constexpr int XC_LD = 272;
constexpr int SCAN_XC = 0, SCAN_OUT = 128 * XC_LD, OUT_LD = 528;
typedef float f32x4s __attribute__((ext_vector_type(4)));
__device__ __forceinline__ int xc_off(int row, int chunk) { return row * XC_LD + (((chunk + 4 * (row >> 4)) & 15) << 4); }
constexpr int SCAN_CW = SCAN_OUT + 128 * OUT_LD;
constexpr int LDS_CARRY = 131072 + 1024;
__device__ __forceinline__ void carry_prep(const Ptrs& P, LAS unsigned char* lds, int vcu, int G, int tid) {
    const f32x2* SUMM = (const f32x2*)(P.ws + WS_SUMM);
#pragma unroll 1
    for (int k2 = 0; k2 < 2; ++k2) {
        const int idx = tid + NTHREADS * k2, ui = idx >> 8, dir = (idx >> 7) & 1, chn = idx & 127;
        const int id = vcu + G * ui, b = id >> 9, ch = (id >> 3) & 63, n = id & 7, gc = n * 128 + chn;
        const int nlist = dir == 0 ? ch : (NCHUNK - 1 - ch);
        const f32x2* base = SUMM + ((size_t)((b * 2 + dir) * NCHUNK)) * 1024 + gc;
        float carry = 0.f;
#pragma unroll 1
        for (int i0 = 0; i0 < nlist; i0 += 16) {
            f32x2 s[16];
#pragma unroll
            for (int i = 0; i < 16; ++i) { const int ii = i0 + i; const int ic = ii < NCHUNK ? ii : NCHUNK - 1; const int c2 = dir == 0 ? ic : (NCHUNK - 1 - ic); s[i] = base[(size_t)c2 * 1024]; }
#pragma unroll
            for (int i = 0; i < 16; ++i) { if (i0 + i < nlist) carry = s[i].x * carry + s[i].y; }
        }
        ((LAS float*)(lds + LDS_CARRY))[idx] = carry;
    }
}
template <bool PASS2>
__device__ __forceinline__ void scan_phase(const Ptrs& P, LAS unsigned char* lds, int l, int vcu, int G, int tid, int wave, int lane) {
    const bf16raw* XR = (const bf16raw*)(P.ws + WS_XR);
    const int n = vcu & 7;
    const int col = lane & 15, q = lane >> 4, dcol = 16 * wave + col, gc = n * 128 + dcol;
    const int cg = tid & 15, tl = tid >> 4, c0 = n * 128 + cg * 8;
    if (tid < 160) { const int g2 = tid / 10, part = tid % 10;
        const float* src = part < 8 ? P.in[3] + (size_t)l * 4 * 1024 + (part >> 1) * 1024 + n * 128 + g2 * 8 + (part & 1) * 4 : P.in[4] + (size_t)l * 1024 + n * 128 + g2 * 8 + (part & 1) * 4;
        *(LAS f32x4*)(lds + SCAN_CW + (g2 * 40 + part * 4) * 4) = *(const f32x4*)src; }
    const bf16raw* WG = (const bf16raw*)(P.ws + WS_WG);
    bf16x8 Bf[2][2][4];
    float br[2], bi[2], nsp2[2];
#pragma unroll
    for (int dir = 0; dir < 2; ++dir) {
#pragma unroll
        for (int gate = 0; gate < 2; ++gate)
#pragma unroll
            for (int ks = 0; ks < 4; ++ks) Bf[dir][gate][ks] = *(const bf16x8*)(WG + (((size_t)((l * 2 + dir) * 2 + gate) * 8 + n) * 128 + dcol) * 128 + 32 * ks + 8 * q);
        br[dir] = -1.4426950408889634f * P.in[6][(size_t)(l * 2 + dir) * 1024 + gc]; bi[dir] = -1.4426950408889634f * P.in[8][(size_t)(l * 2 + dir) * 1024 + gc];
        nsp2[dir] = -1.4426950408889634f * ((const float*)(P.ws + WS_SP))[(size_t)(l * 2 + dir) * 1024 + gc];
    }
    bf16x8 Bsel;
    { const int jt = 16 * (wave & 1) + col - 8 * q; v4u w;
      w.x = (jt == 0 ? 0x3F80u : 0u) | (jt == 1 ? 0x3F800000u : 0u); w.y = (jt == 2 ? 0x3F80u : 0u) | (jt == 3 ? 0x3F800000u : 0u);
      w.z = (jt == 4 ? 0x3F80u : 0u) | (jt == 5 ? 0x3F800000u : 0u); w.w = (jt == 6 ? 0x3F80u : 0u) | (jt == 7 ? 0x3F800000u : 0u);
      Bsel = __builtin_bit_cast(bf16x8, w); }
    const int wsel = wave >> 1;
    v4u xraw[7];
#define SCAN_LOAD_ROWS(unit_id) do { const int b_ = (unit_id) >> 9, t0_ = (((unit_id) >> 3) & 63) * CHUNK; _Pragma("unroll") for (int i = 0; i < 7; ++i) { const int t = t0_ + 4 * tl - 2 + i; const int tc = t < 0 ? 0 : (t >= SEQ ? SEQ - 1 : t); \
        v4u raw_ = *(const v4u*)(XR + ((size_t)(b_ * SEQ + tc)) * 1024 + c0); if (t != tc) raw_ = (v4u){0u, 0u, 0u, 0u}; xraw[i] = raw_; } } while (0)
    SCAN_LOAD_ROWS(vcu);
    __syncthreads();
#pragma unroll 1
    for (int k = 0; k < 4; ++k) {
        const int id = vcu + G * k, b = id >> 9, ch = (id >> 3) & 63, t0 = ch * CHUNK;
        v4u ygv[4];
        {
            float w[4][8], bb[8];
            const LAS f32x4* cw = (const LAS f32x4*)(lds + SCAN_CW + cg * 160);
#pragma unroll
            for (int tap = 0; tap < 4; ++tap) { const f32x4 a = cw[2 * tap], c = cw[2 * tap + 1];
                w[tap][0] = a[0]; w[tap][1] = a[1]; w[tap][2] = a[2]; w[tap][3] = a[3]; w[tap][4] = c[0]; w[tap][5] = c[1]; w[tap][6] = c[2]; w[tap][7] = c[3]; }
            { const f32x4 a = cw[8], c = cw[9]; bb[0] = a[0]; bb[1] = a[1]; bb[2] = a[2]; bb[3] = a[3]; bb[4] = c[0]; bb[5] = c[1]; bb[6] = c[2]; bb[7] = c[3]; }
            float xv[7][8];
#pragma unroll
            for (int i = 0; i < 7; ++i) { const v4u raw = xraw[i];
                xv[i][0] = bflo(raw.x); xv[i][1] = bfhi(raw.x); xv[i][2] = bflo(raw.y); xv[i][3] = bfhi(raw.y); xv[i][4] = bflo(raw.z); xv[i][5] = bfhi(raw.z); xv[i][6] = bflo(raw.w); xv[i][7] = bfhi(raw.w); }
#pragma unroll
            for (int j = 0; j < 4; ++j) { float o[8];
#pragma unroll
                for (int e = 0; e < 8; ++e) o[e] = bb[e] + w[0][e] * xv[j][e] + w[1][e] * xv[j + 1][e] + w[2][e] * xv[j + 2][e] + w[3][e] * xv[j + 3][e];
                v4u pk; pk.x = pk2(o[0], o[1]); pk.y = pk2(o[2], o[3]); pk.z = pk2(o[4], o[5]); pk.w = pk2(o[6], o[7]);
                *(LAS v4u*)(lds + SCAN_XC + xc_off(4 * tl + j, cg)) = pk; }
        }
        __syncthreads();
        if (k + 1 < 4) SCAN_LOAD_ROWS(vcu + G * (k + 1));
#pragma unroll
        for (int dir = 0; dir < 2; ++dir) {
            float carry = 0.f, atot = 1.f;
            if (PASS2) carry = ((const LAS float*)(lds + LDS_CARRY))[(k * 2 + dir) * 128 + dcol];
#pragma unroll 1
            for (int hh = 0; hh < 2; ++hh) {
                const int tb = 64 * (dir == 0 ? hh : 1 - hh);
                float e1[16], e2[16], xq[16];
#pragma unroll
                for (int i = 0; i < 4; ++i) {
                    const int row = tb + 16 * (col >> 2) + 4 * i + (col & 3);
                    f32x4s accr = {br[dir], br[dir], br[dir], br[dir]}, acci = {bi[dir], bi[dir], bi[dir], bi[dir]}, accx = {0.f, 0.f, 0.f, 0.f};
#pragma unroll
                    for (int ks = 0; ks < 4; ++ks) { const bf16x8 a = *(const LAS bf16x8*)(lds + SCAN_XC + xc_off(row, 4 * ks + q));
                        accr = __builtin_amdgcn_mfma_f32_16x16x32_bf16(a, Bf[dir][0][ks], accr, 0, 0, 0);
                        acci = __builtin_amdgcn_mfma_f32_16x16x32_bf16(a, Bf[dir][1][ks], acci, 0, 0, 0); }
                    { const bf16x8 a = *(const LAS bf16x8*)(lds + SCAN_XC + xc_off(row, 4 * wsel + q)); accx = __builtin_amdgcn_mfma_f32_16x16x32_bf16(a, Bsel, accx, 0, 0, 0); }
#pragma unroll
                    for (int j = 0; j < 4; ++j) { e1[4 * i + j] = accr[j]; e2[4 * i + j] = acci[j]; xq[4 * i + j] = accx[j]; }
                }
                float av[16], uv[16];
#pragma unroll
                for (int t = 0; t < 16; ++t) { e1[t] = __builtin_amdgcn_exp2f(e1[t]); e2[t] = __builtin_amdgcn_exp2f(e2[t]); }
#pragma unroll
                for (int t = 0; t < 16; ++t) { e1[t] = __builtin_amdgcn_rcpf(1.f + e1[t]); e2[t] = __builtin_amdgcn_rcpf(1.f + e2[t]); }
#pragma unroll
                for (int t = 0; t < 16; ++t) av[t] = __builtin_amdgcn_exp2f(nsp2[dir] * e1[t]);
#pragma unroll
                for (int t = 0; t < 16; ++t) uv[t] = xq[t] * e2[t] * __builtin_amdgcn_sqrtf(__builtin_fmaf(-av[t], av[t], 1.f));
                float Pc[16], Sc[16];
                if (dir == 0) { Pc[0] = av[0]; Sc[0] = uv[0];
#pragma unroll
                    for (int t = 1; t < 16; ++t) { Pc[t] = Pc[t - 1] * av[t]; Sc[t] = av[t] * Sc[t - 1] + uv[t]; } }
                else { Pc[15] = av[15]; Sc[15] = uv[15];
#pragma unroll
                    for (int t = 14; t >= 0; --t) { Pc[t] = Pc[t + 1] * av[t]; Sc[t] = av[t] * Sc[t + 1] + uv[t]; } }
                const float Pa = dir == 0 ? Pc[15] : Pc[0], Sa = dir == 0 ? Sc[15] : Sc[0];
                float hs = carry, run = carry;
#pragma unroll
                for (int k = 0; k < 4; ++k) { const int qq = dir == 0 ? k : 3 - k;
                    const float Ak = bperm_f(col + 16 * qq, Pa), Hk = bperm_f(col + 16 * qq, Sa);
                    if (qq == q) hs = run;
                    run = Ak * run + Hk; atot *= Ak; }
                carry = run;
                if (PASS2) {
#pragma unroll
                    for (int t = 0; t < 16; ++t) { const float h = Sc[t] + Pc[t] * hs;
                        LAS float* op = (LAS float*)(lds + SCAN_OUT + (tb + 16 * q + t) * OUT_LD + dcol * 4);
                        if (dir == 0) *op = h; else *op = *op + h; }
                }
            }
            if (!PASS2) { if (q == 0) ((f32x2*)(P.ws + WS_SUMM))[((size_t)((b * 2 + dir) * NCHUNK + ch)) * 1024 + gc] = (f32x2){atot, carry}; }
        }
        if (PASS2) {
            { const bf16raw* YGp = (const bf16raw*)(P.ws + WS_YG);
#pragma unroll
              for (int j = 0; j < 4; ++j) ygv[j] = *(const v4u*)(YGp + ((size_t)(b * SEQ + t0 + 4 * tl + j)) * 1024 + c0); }
            __syncthreads();
            bf16raw* HG = (bf16raw*)(P.ws + WS_HG);
#pragma unroll
            for (int j = 0; j < 4; ++j) { const int t = t0 + 4 * tl + j; const size_t go = ((size_t)(b * SEQ + t)) * 1024 + c0;
                const f32x4 h0 = *(const LAS f32x4*)(lds + SCAN_OUT + (4 * tl + j) * OUT_LD + cg * 32), h1 = *(const LAS f32x4*)(lds + SCAN_OUT + (4 * tl + j) * OUT_LD + cg * 32 + 16); const v4u yv = ygv[j];
                v4u o; o.x = pk2(h0[0] * bflo(yv.x), h0[1] * bfhi(yv.x)); o.y = pk2(h0[2] * bflo(yv.y), h0[3] * bfhi(yv.y));
                o.z = pk2(h1[0] * bflo(yv.z), h1[1] * bfhi(yv.z)); o.w = pk2(h1[2] * bflo(yv.w), h1[3] * bfhi(yv.w));
                *(v4u*)(HG + go) = o; }
        }
        __syncthreads();
    }
#undef SCAN_LOAD_ROWS
}

constexpr int RT_XH = 0, RT_XL = 65536;
constexpr int RT_PART = 0, RT_LOGIT = 49152;
__device__ __forceinline__ void ln1_router_phase(const Ptrs& P, LAS unsigned char* lds, int l, int vcu, int G, int tid, int wave, int lane) {
    const float* X1 = (const float*)(P.ws + WS_X1); float* X1O = P.out;
    bf16raw* XB = (bf16raw*)(P.ws + WS_XB);
    const float* gam = P.in[13] + (size_t)(l * 2 + 0) * 1024; const float* bet = P.in[14] + (size_t)(l * 2 + 0) * 1024;
    const bf16raw* WRH = (const bf16raw*)(P.ws + WS_WR) + (size_t)l * 48 * 1024; const bf16raw* WRL = WRH + (size_t)DEPTH * 48 * 1024;
    LAS int* lcnt = (LAS int*)(lds + LDS_CARRY);
    if (tid < NEXP) lcnt[tid] = 0;
    int* tok_e = (int*)(P.ws + WS_ROUTE + RT_TOKE); int* tok_pos = (int*)(P.ws + WS_ROUTE + RT_TOKPOS); float* tok_w = (float*)(P.ws + WS_ROUTE + RT_TOKW);
    f32x4 gv[4], bv[4];
#pragma unroll
    for (int j = 0; j < 4; ++j) { gv[j] = *(const f32x4*)(gam + 4 * lane + 256 * j); bv[j] = *(const f32x4*)(bet + 4 * lane + 256 * j); }
    const int col = lane & 15, q = lane >> 4;
#pragma unroll 1
    for (int pass = 0; pass < 2; ++pass) {
        const int mb = vcu * 64 + pass * 32;
#pragma unroll
        for (int r = 0; r < 4; ++r) {
            const int lr = wave * 4 + r; const size_t go = (size_t)(mb + lr) * 1024;
            f32x4 x[4]; float s = 0.f;
#pragma unroll
            for (int j = 0; j < 4; ++j) { x[j] = *(const f32x4*)(X1 + go + 4 * lane + 256 * j); s += (x[j][0] + x[j][1]) + (x[j][2] + x[j][3]); }
            const float mean = wave_sum(s) * (1.f / 1024.f); float s2 = 0.f;
#pragma unroll
            for (int j = 0; j < 4; ++j) { x[j] = x[j] - mean; s2 += (x[j][0] * x[j][0] + x[j][1] * x[j][1]) + (x[j][2] * x[j][2] + x[j][3] * x[j][3]); }
            const float rstd = 1.f / sqrtf(wave_sum(s2) * (1.f / 1024.f) + LN_EPS);
#pragma unroll
            for (int j = 0; j < 4; ++j) { x[j] = x[j] * rstd * gv[j] + bv[j];
                *(f32x4*)(X1O + go + 4 * lane + 256 * j) = x[j];
                const unsigned h0 = f2bf(x[j][0]), h1 = f2bf(x[j][1]), h2 = f2bf(x[j][2]), h3 = f2bf(x[j][3]);
                v2u hv; hv.x = h0 | (h1 << 16); hv.y = h2 | (h3 << 16);
                *(v2u*)(XB + go + 4 * lane + 256 * j) = hv;
                v2u lv; lv.x = pk2(x[j][0] - __builtin_bit_cast(float, h0 << 16), x[j][1] - __builtin_bit_cast(float, h1 << 16)); lv.y = pk2(x[j][2] - __builtin_bit_cast(float, h2 << 16), x[j][3] - __builtin_bit_cast(float, h3 << 16));
                const int off = lr * 2048 + (((32 * j + (lane >> 1)) ^ (lr & 15)) << 4) + (lane & 1) * 8;
                *(LAS v2u*)(lds + RT_XH + off) = hv; *(LAS v2u*)(lds + RT_XL + off) = lv; }
        }
        bf16x8 Bh[4][3], Bl[4][3];
#pragma unroll
        for (int ks = 0; ks < 4; ++ks)
#pragma unroll
            for (int nt = 0; nt < 3; ++nt) { const size_t wo = (size_t)(16 * nt + col) * 1024 + 32 * (wave * 4 + ks) + 8 * q;
                Bh[ks][nt] = *(const bf16x8*)(WRH + wo); Bl[ks][nt] = *(const bf16x8*)(WRL + wo); }
        __syncthreads();
        f32x4 acc[2][3];
#pragma unroll
        for (int m = 0; m < 2; ++m)
#pragma unroll
            for (int nt = 0; nt < 3; ++nt) acc[m][nt] = (f32x4){0.f, 0.f, 0.f, 0.f};
#pragma unroll
        for (int ks = 0; ks < 4; ++ks)
#pragma unroll
            for (int m = 0; m < 2; ++m) { const int row = 16 * m + col; const int off = row * 2048 + (((4 * (wave * 4 + ks) + q) ^ (row & 15)) << 4);
                const bf16x8 ah = *(const LAS bf16x8*)(lds + RT_XH + off), al = *(const LAS bf16x8*)(lds + RT_XL + off);
#pragma unroll
                for (int nt = 0; nt < 3; ++nt) { acc[m][nt] = __builtin_amdgcn_mfma_f32_16x16x32_bf16(ah, Bh[ks][nt], acc[m][nt], 0, 0, 0);
                    acc[m][nt] = __builtin_amdgcn_mfma_f32_16x16x32_bf16(al, Bh[ks][nt], acc[m][nt], 0, 0, 0);
                    acc[m][nt] = __builtin_amdgcn_mfma_f32_16x16x32_bf16(ah, Bl[ks][nt], acc[m][nt], 0, 0, 0); } }
        __syncthreads();
#pragma unroll
        for (int m = 0; m < 2; ++m)
#pragma unroll
            for (int nt = 0; nt < 3; ++nt) *(LAS f32x4*)(lds + RT_PART + ((wave * 6 + m * 3 + nt) * 256 + lane * 4) * 4) = acc[m][nt];
        __syncthreads();
#pragma unroll
        for (int i = 0; i < 3; ++i) { const int idx = tid + NTHREADS * i, t = idx >> 8, p = idx & 255; float s = 0.f;
#pragma unroll
            for (int w = 0; w < 8; ++w) s += *(const LAS float*)(lds + RT_PART + ((w * 6 + t) * 256 + p) * 4);
            const int ll = p >> 2, j = p & 3, token = 16 * (t / 3) + 4 * (ll >> 4) + j, o = 16 * (t % 3) + (ll & 15);
            const float bias = o < 4 ? P.in[16][l * 4 + o] : (o < 36 ? P.in[18][l * 32 + o - 4] : 0.f);
            *(LAS float*)(lds + RT_LOGIT + (token * 48 + o) * 4) = s + bias; }
        __syncthreads();
        if (tid < 32) {
            const LAS float* lg = (const LAS float*)(lds + RT_LOGIT + tid * 192);
            int gi = 0; float gm = lg[0];
#pragma unroll
            for (int k = 1; k < 4; ++k) { const float v = lg[k]; if (v > gm) { gm = v; gi = k; } }
            float den = 0.f;
#pragma unroll
            for (int k = 0; k < 4; ++k) den += expf(lg[k] - gm);
            const float gval = 1.f / den;
            const LAS float* eg = lg + 4 + 8 * gi;
            int i1 = 0; float v1 = eg[0];
#pragma unroll
            for (int k = 1; k < 8; ++k) { const float v = eg[k]; if (v > v1) { v1 = v; i1 = k; } }
            int i2 = -1; float v2 = 0.f;
#pragma unroll
            for (int k = 0; k < 8; ++k) { const float v = eg[k]; if (k != i1 && (i2 < 0 || v > v2)) { v2 = v; i2 = k; } }
            const float ex = expf(v2 - v1), w1 = gval / (1.f + ex), w2 = gval * ex / (1.f + ex);
            const int m = mb + tid, e1 = gi * 8 + i1, e2 = gi * 8 + i2;
            const int p1 = __hip_atomic_fetch_add(lcnt + e1, 1, __ATOMIC_RELAXED, __HIP_MEMORY_SCOPE_WORKGROUP), p2 = __hip_atomic_fetch_add(lcnt + e2, 1, __ATOMIC_RELAXED, __HIP_MEMORY_SCOPE_WORKGROUP);
            tok_e[2 * m] = e1; tok_pos[2 * m] = p1; tok_w[2 * m] = w1; tok_e[2 * m + 1] = e2; tok_pos[2 * m + 1] = p2; tok_w[2 * m + 1] = w2;
        }
        __syncthreads();
    }
    if (tid < NEXP) ((int*)(P.ws + WS_ROUTE + RT_BLKCNT))[vcu * NEXP + tid] = lcnt[tid];
    __syncthreads();
}
__device__ __forceinline__ void gather_phase(const Ptrs& P, LAS unsigned char* lds, int l, int vcu, int G, int tid, int wave, int lane) {
    LAS int* ps = (LAS int*)lds;
    const int* blkcnt = (const int*)(P.ws + WS_ROUTE + RT_BLKCNT);
    { const int e = tid & 31, part = tid >> 5; int tot = 0, pre = 0;
#pragma unroll
        for (int i = 0; i < 16; ++i) { const int b2 = part * 16 + i; const int c = blkcnt[b2 * NEXP + e]; tot += c; pre += b2 < vcu ? c : 0; }
        ps[256 + part * 32 + e] = tot; ps[768 + part * 32 + e] = pre; }
    __syncthreads();
    if (tid < NEXP) { int tot = 0, pre = 0;
#pragma unroll
        for (int p2 = 0; p2 < 16; ++p2) { tot += ps[256 + p2 * 32 + tid]; pre += ps[768 + p2 * 32 + tid]; }
        ps[64 + tid] = tot; ps[128 + tid] = pre; }
    __syncthreads();
    if (tid == 0) { int acc = 0; for (int e = 0; e < NEXP; ++e) { ps[e] = acc; acc += (ps[64 + e] + 255) & ~255; } ps[32] = acc; }
    __syncthreads();
    const int* tok_e = (const int*)(P.ws + WS_ROUTE + RT_TOKE); const int* tok_pos = (const int*)(P.ws + WS_ROUTE + RT_TOKPOS); const float* tok_w = (const float*)(P.ws + WS_ROUTE + RT_TOKW);
    int* slot = (int*)(P.ws + WS_ROUTE + RT_SLOT); float* roww = (float*)(P.ws + WS_ROUTE + RT_ROWW); int* tile_e = (int*)(P.ws + WS_ROUTE + RT_TILEE);
    const bf16raw* XB = (const bf16raw*)(P.ws + WS_XB); bf16raw* XS = (bf16raw*)(P.ws + WS_XS);
    for (int i = 0; i < 16; ++i) { const int a = vcu * 128 + wave * 16 + i;
        const int e = tok_e[a], dest = ps[e] + ps[128 + e] + tok_pos[a];
        const v4u* src = (const v4u*)(XB + (size_t)(a >> 1) * 1024); v4u* dst = (v4u*)(XS + (size_t)dest * 1024);
        const v4u a0 = src[lane], a1 = src[64 + lane]; dst[lane] = a0; dst[64 + lane] = a1;
        if (lane == 0) { slot[dest] = a; roww[dest] = tok_w[a]; }
    }
    const int total = ps[32];
    for (int r = (vcu * NTHREADS + tid); r < total; r += G * NTHREADS) {
        int e = 0;
#pragma unroll 1
        for (int k = 1; k < NEXP; ++k) if (r >= ps[k]) e = k;
        if (r - ps[e] >= ps[64 + e]) { slot[r] = -1; roww[r] = 0.f; }
    }
    if (vcu == 0) {
        const int nt = total >> 8;
        for (int t = tid; t < nt; t += NTHREADS) { int e = 0;
#pragma unroll 1
            for (int k = 1; k < NEXP; ++k) if (t * 256 >= ps[k]) e = k;
            tile_e[t] = e; }
        if (tid == 0) tile_e[MOE_TILES_MAX] = nt;
    }
    __syncthreads();
}
__device__ __forceinline__ void ln2_phase(const Ptrs& P, int l, float* dstf, bool use_moe, int vcu, int G, int wave, int lane) {
    const float* X1 = P.out; bf16raw* XB = (bf16raw*)(P.ws + WS_XB); const bf16raw* YB = (const bf16raw*)(P.ws + WS_YB);
    const float* gam = P.in[13] + (size_t)(l * 2 + 1) * 1024; const float* bet = P.in[14] + (size_t)(l * 2 + 1) * 1024;
    const int gw = vcu * NWAVES + wave, NGW = G * NWAVES;
    f32x4 gv[4], bv[4];
#pragma unroll
    for (int j = 0; j < 4; ++j) { gv[j] = *(const f32x4*)(gam + 4 * lane + 256 * j); bv[j] = *(const f32x4*)(bet + 4 * lane + 256 * j); }
    for (int m = gw; m < TOK; m += NGW) {
        f32x4 x[4]; float s = 0.f;
#pragma unroll
        for (int j = 0; j < 4; ++j) { x[j] = *(const f32x4*)(X1 + (size_t)m * 1024 + 4 * lane + 256 * j) * ALPHA;
            if (use_moe) { const v2u y0 = *(const v2u*)(YB + (size_t)(2 * m) * 1024 + 4 * lane + 256 * j), y1 = *(const v2u*)(YB + (size_t)(2 * m + 1) * 1024 + 4 * lane + 256 * j);
                x[j][0] += bflo(y0.x) + bflo(y1.x); x[j][1] += bfhi(y0.x) + bfhi(y1.x); x[j][2] += bflo(y0.y) + bflo(y1.y); x[j][3] += bfhi(y0.y) + bfhi(y1.y); }
            s += (x[j][0] + x[j][1]) + (x[j][2] + x[j][3]); }
        const float mean = wave_sum(s) * (1.f / 1024.f); float s2 = 0.f;
#pragma unroll
        for (int j = 0; j < 4; ++j) { x[j] = x[j] - mean; s2 += (x[j][0] * x[j][0] + x[j][1] * x[j][1]) + (x[j][2] * x[j][2] + x[j][3] * x[j][3]); }
        const float rstd = 1.f / sqrtf(wave_sum(s2) * (1.f / 1024.f) + LN_EPS);
#pragma unroll
        for (int j = 0; j < 4; ++j) { x[j] = x[j] * rstd * gv[j] + bv[j];
            *(f32x4*)(dstf + (size_t)m * 1024 + 4 * lane + 256 * j) = x[j];
            v2u o; o.x = pk2(x[j][0], x[j][1]); o.y = pk2(x[j][2], x[j][3]);
            *(v2u*)(XB + (size_t)m * 1024 + 4 * lane + 256 * j) = o; }
    }
}
__device__ __forceinline__ void resid_only_phase(const Ptrs& P, const float* xin, int vcu, int G, int wave, int lane) {
    float* X1 = (float*)(P.ws + WS_X1); const int gt = (vcu * NWAVES + wave) * 64 + lane, NGT = G * NTHREADS;
    for (int i = gt; i < TOK * DM / 4; i += NGT) *(f32x4*)(X1 + (size_t)i * 4) = *(const f32x4*)(xin + (size_t)i * 4) * ALPHA;
}

constexpr int N_PHASES = 1 + 10 * DEPTH;
#ifndef ONLY_S
#define ONLY_S -1
#endif
#define PH_ON(k) (ONLY_S < 0 || ONLY_S == (k))
#ifndef REP_MASK
#define REP_MASK 0
#endif
#define REPS(bit) (((REP_MASK >> (bit)) & 1) ? 2 : 1)
struct Args { const float* in[22]; float* out; unsigned char* ws; int ph_lo, ph_hi, sub, pad; };

__device__ __forceinline__ attn::BlockRef<attn::bf16, attn::bf16> attn_block(const Ptrs& P, int l, int id) {
    const int hq = id & 3, qb = (id >> 2) & 31, g = (id >> 7) & 1, b = id >> 8;
    attn::BlockRef<attn::bf16, attn::bf16> r;
    const size_t row0 = (size_t)b * SEQ + (size_t)qb * 256;
    r.Q = (const attn::bf16*)(P.ws + WS_Q) + row0 * 1024 + (g * 4 + hq) * 128;
    r.O = (attn::bf16*)(P.ws + WS_AO) + row0 * 1024 + (g * 4 + hq) * 128;
    r.K = (const attn::bf16*)(P.ws + WS_K) + (size_t)b * SEQ * 256 + g * 128;
    r.V = (const attn::bf16*)(P.ws + WS_V) + (size_t)b * SEQ * 256 + g * 128;
    r.P0 = qb * 256; r.sinkl2 = P.in[2][l * 8 + g * 4 + hq] * 1.4426950408889634f;
    return r;
}

__global__ void __launch_bounds__(NTHREADS, 2) fwd_kernel(Args args) {
    extern __shared__ __attribute__((aligned(16))) unsigned char lds_raw[];
    LAS unsigned char* lds = (LAS unsigned char*)lds_raw;
    const int tid0 = threadIdx.x;
    const int G = gridDim.x, bx = blockIdx.x, vcu = (G % 8 == 0) ? (bx % 8) * (G / 8) + bx / 8 : bx;
    const int lo = args.ph_lo, hi = args.ph_hi, sub = args.sub;
    for (int u = tid0; u < (LDS_BYTES - 131072) / 4; u += NTHREADS) ((LAS unsigned*)(lds + 131072))[u] = 0u;
    __syncthreads();
    XcdBarrier bar; bar.bar = (unsigned*)(args.ws + WS_CTL) + CW_BAR; bar.x = 0; bar.st = nullptr;
    if (hi - lo > 1) bar = xcd_barrier_post((unsigned*)(args.ws + WS_CTL) + CW_BAR, (volatile LAS unsigned*)(lds + 131072 + 320) + 8);
    constexpr bool EN_MIX = (EN_ATTN || EN_RNN);

    if (lo == 0) {
        Ptrs P0;
#pragma unroll
        for (int i = 0; i < 22; ++i) P0.in[i] = args.in[i];
        P0.out = args.out; P0.ws = args.ws;
        if (PH_ON(10)) p0_prologue(P0, lds, vcu, G, __builtin_amdgcn_readfirstlane(tid0 >> 6), tid0 & 63);
        if (hi > 1) xcd_barrier(bar);
    }
    for (int ph = (lo == 0 ? 1 : lo); ph < hi; ++ph) {
        int tid_ = threadIdx.x; asm volatile("" : "+v"(tid_));
        const int tid = tid_, lane = tid & 63, wave = __builtin_amdgcn_readfirstlane(tid >> 6);
        const __attribute__((address_space(4))) unsigned char* kap = (const __attribute__((address_space(4))) unsigned char*)__builtin_amdgcn_kernarg_segment_ptr();
        asm volatile("" : "+s"(kap));
        const __attribute__((address_space(4))) Args* ap = (const __attribute__((address_space(4))) Args*)kap;
        Ptrs P;
#pragma unroll
        for (int i = 0; i < 22; ++i) P.in[i] = ap->in[i];
        P.out = ap->out; P.ws = ap->ws;
        unsigned char* ws = P.ws;
        bf16raw* XB = (bf16raw*)(ws + WS_XB); float* X1 = (float*)(ws + WS_X1); float* XRES = (float*)(ws + WS_XRES);
        bf16raw* Qb = (bf16raw*)(ws + WS_Q); bf16raw* Kb = (bf16raw*)(ws + WS_K); bf16raw* Vb = (bf16raw*)(ws + WS_V); bf16raw* XRb = (bf16raw*)(ws + WS_XR);
        bf16raw* YG = (bf16raw*)(ws + WS_YG); bf16raw* GA = (bf16raw*)(ws + WS_GA); bf16raw* GR = (bf16raw*)(ws + WS_GR);
        bf16raw* AO = (bf16raw*)(ws + WS_AO); bf16raw* HG = (bf16raw*)(ws + WS_HG); bf16raw* YA = (bf16raw*)(ws + WS_YA); bf16raw* MG = (bf16raw*)(ws + WS_MG);
        bf16raw* XS = (bf16raw*)(ws + WS_XS); bf16raw* HID = (bf16raw*)(ws + WS_HID); bf16raw* YB = (bf16raw*)(ws + WS_YB);
        {
            const int l = (ph - 1) / 10, s = (ph - 1) % 10;
            const float* xin = l == 0 ? P.in[0] : XRES;
            if (s == 0 && PH_ON(0)) {
                if (EN_MIX) {
                    pg8::Gemm g{XB, (const bf16raw*)(ws + WS_WIN) + (size_t)l * NIN * DM, TOK, NIN, DM}; pg8::StaticOrder S; S.init(TOK, NIN, G, bx);
                    pg8::EpiInProj E{Qb, Kb, Vb, XRb, YG, GA, GR, (const float*)(ws + WS_RCOS), (const float*)(ws + WS_RSIN)};
                    pg8::gemm_phase<pg8::EpiInProj, pg8::StaticOrder, true, true>(lds, g, S, E);
                }
            } else if (s == 1 && PH_ON(1)) {
                if (EN_ATTN && (sub & 1)) {
                    attn::Seam<attn::bf16> SM;
                    const attn::BlockRef<attn::bf16, attn::bf16> b0 = attn_block(P, l, 2 * vcu), b1 = attn_block(P, l, 2 * vcu + 1);
                    attn::causal_swa_prime<attn::bf16, attn::bf16>(b0, WIN, (char*)lds_raw, SM);
                    attn::causal_swa_block<attn::bf16, attn::bf16>(b0, b1, SEQ, WIN, (char*)lds_raw, SM);
                    attn::causal_swa_block<attn::bf16, attn::bf16>(b1, b1, SEQ, WIN, (char*)lds_raw, SM);
                    __syncthreads();
                }
                if (EN_RNN && (sub & 2)) {
                    scan_phase<false>(P, lds, l, vcu, G, tid, wave, lane);
                }
            } else if (s == 2 && PH_ON(2)) {
                if (EN_RNN && (sub & 2)) carry_prep(P, lds, vcu, G, tid);
                if (EN_ATTN && (sub & 1)) {
                    pg8::Gemm g{AO, (const bf16raw*)(ws + WS_WAO) + (size_t)l * DM * DM, TOK, DM, DM}; pg8::StaticOrder S; S.init(TOK, DM, G, bx);
                    pg8::EpiGate E{GA, nullptr, YA};
                    pg8::gemm_phase<pg8::EpiGate, pg8::StaticOrder, true, true>(lds, g, S, E);
                    __syncthreads();
                }
                if (EN_RNN && (sub & 2)) {
                    scan_phase<true>(P, lds, l, vcu, G, tid, wave, lane);
                }
            } else if (s == 3 && PH_ON(3)) {
                if (EN_RNN) {
                    pg8::Gemm g{HG, (const bf16raw*)(ws + WS_WRO) + (size_t)l * DM * DM, TOK, DM, DM}; pg8::StaticOrder S; S.init(TOK, DM, G, bx);
                    pg8::EpiGate E{GR, EN_ATTN ? YA : nullptr, MG};
                    pg8::gemm_phase<pg8::EpiGate, pg8::StaticOrder, true, true>(lds, g, S, E);
                }
            } else if (s == 4 && PH_ON(4)) {
                if (EN_MIX) {
                    pg8::Gemm g{EN_RNN ? MG : YA, (const bf16raw*)(ws + WS_WOUT) + (size_t)l * DM * DM, TOK, DM, DM}; pg8::StaticOrder S; S.init(TOK, DM, G, bx);
                    pg8::EpiResid E{xin, X1, ALPHA};
                    pg8::gemm_phase<pg8::EpiResid, pg8::StaticOrder, true, true>(lds, g, S, E);
                } else resid_only_phase(P, xin, vcu, G, wave, lane);
            } else if (s == 5 && PH_ON(5)) {
                ln1_router_phase(P, lds, l, vcu, G, tid, wave, lane);
            } else if (s == 6 && PH_ON(6)) {
                if (EN_MOE) gather_phase(P, lds, l, vcu, G, tid, wave, lane);
            } else if (s == 7 && PH_ON(7)) {
                if (EN_MOE) {
                    const int* tile_e = (const int*)(ws + WS_ROUTE + RT_TILEE); const int nt = __builtin_amdgcn_readfirstlane(tile_e[MOE_TILES_MAX]);
                    pg8::Gemm g{XS, (const bf16raw*)(ws + WS_WGU) + (size_t)l * NEXP * 1024 * DM, nt * 256, 1024, DM}; pg8::MoeOrder S{tile_e, nt * 4, G, vcu};
                    pg8::EpiSwiGLU E{HID};
                    pg8::gemm_phase<pg8::EpiSwiGLU, pg8::MoeOrder, true, true>(lds, g, S, E);
                }
            } else if (s == 8 && PH_ON(8)) {
                if (EN_MOE) {
                    const int* tile_e = (const int*)(ws + WS_ROUTE + RT_TILEE); const int nt = __builtin_amdgcn_readfirstlane(tile_e[MOE_TILES_MAX]);
                    pg8::Gemm g{HID, (const bf16raw*)(ws + WS_WD) + (size_t)l * NEXP * DM * DEXP, nt * 256, 1024, DEXP}; pg8::MoeOrder S{tile_e, nt * 4, G, vcu};
                    pg8::EpiDown E{(const int*)(ws + WS_ROUTE + RT_SLOT), (const float*)(ws + WS_ROUTE + RT_ROWW), YB};
                    pg8::gemm_phase<pg8::EpiDown, pg8::MoeOrder, true, true>(lds, g, S, E);
                }
            } else if (PH_ON(9)) {
                ln2_phase(P, l, l == DEPTH - 1 ? P.out : XRES, EN_MOE != 0, vcu, G, wave, lane);
            }
        }
        if (ph + 1 < hi) { xcd_barrier(bar);
#if defined(BAR_TWICE)
            xcd_barrier(bar);
#endif
        }
    }
}

extern "C" void kernel_launch(void* const* d_in, const int* in_sizes, int n_in, void* d_out, int out_size, void* d_ws, size_t ws_size, hipStream_t stream) {
    static int grid = 0;
    if (grid == 0) {
        if (n_in != 22 || in_sizes[0] != TOK * DM || out_size != TOK * DM || ws_size < WS_END) { fprintf(stderr, "kernel_launch: unexpected shapes (n_in %d, in0 %d, out %d, ws %zu)\n", n_in, n_in > 0 ? in_sizes[0] : -1, out_size, ws_size); grid = -1; return; }
        int dev = 0, cus = 0, per_cu = 0;
        if (hipGetDevice(&dev) != hipSuccess || hipDeviceGetAttribute(&cus, hipDeviceAttributeMultiprocessorCount, dev) != hipSuccess) { grid = -1; return; }
        if (hipFuncSetAttribute((const void*)fwd_kernel, hipFuncAttributeMaxDynamicSharedMemorySize, LDS_BYTES) != hipSuccess) { fprintf(stderr, "kernel_launch: hipFuncSetAttribute failed\n"); grid = -1; return; }
        if (hipOccupancyMaxActiveBlocksPerMultiprocessor(&per_cu, (const void*)fwd_kernel, NTHREADS, LDS_BYTES) != hipSuccess || per_cu < 1) fprintf(stderr, "kernel_launch: occupancy query reports %d\n", per_cu);
        (void)hipGetLastError();
        grid = cus;
        if (grid != 256) { fprintf(stderr, "kernel_launch: built for 256 CUs, device has %d\n", cus); grid = -1; return; }
    }
    if (grid < 0) return;
    if (hipMemsetAsync((char*)d_ws + WS_CTL, 0, CTL_ZERO_BYTES, stream) != hipSuccess) { fprintf(stderr, "kernel_launch: hipMemsetAsync failed\n"); return; }
    Args a{};
    for (int i = 0; i < 22; ++i) a.in[i] = (const float*)d_in[i];
    a.out = (float*)d_out; a.ws = (unsigned char*)d_ws;
#if MK_ONE_LAUNCH
    a.ph_lo = 0; a.ph_hi = N_PHASES; a.sub = 3;
    void* params[] = {&a};
    const hipError_t le = hipLaunchCooperativeKernel((const void*)fwd_kernel, dim3(grid), dim3(NTHREADS), params, LDS_BYTES, stream);
    if (le != hipSuccess) fprintf(stderr, "kernel_launch: cooperative launch failed: %s\n", hipGetErrorName(le));
#else
    for (int ph = 0; ph < N_PHASES; ++ph) {
        a.ph_lo = ph; a.ph_hi = ph + 1;
        const int s = ph == 0 ? 10 : (ph - 1) % 10;
        if (REP_MASK != 0 && (s == 1 || s == 2)) {
            for (int part = 1; part <= 2; ++part) { a.sub = part; const int bit = s == 1 ? 10 + part : 12 + part;
                for (int rep = 0; rep < REPS(bit) * REPS(s); ++rep) hipLaunchKernelGGL(fwd_kernel, dim3(grid), dim3(NTHREADS), LDS_BYTES, stream, a); }
        } else { a.sub = 3; for (int rep = 0; rep < REPS(s); ++rep) hipLaunchKernelGGL(fwd_kernel, dim3(grid), dim3(NTHREADS), LDS_BYTES, stream, a); }
    }
#endif
}
```

```cpp
#include <hip/hip_runtime.h>
#include <hip/hip_bf16.h>
#include <cstdio>
#include <cstdint>

#ifndef MK_ONE_LAUNCH
#define MK_ONE_LAUNCH 1
#endif
#ifndef EN_ATTN
#define EN_ATTN 1
#endif
#ifndef EN_RNN
#define EN_RNN 1
#endif
#ifndef EN_MOE
#define EN_MOE 1
#endif

constexpr int DM = 1024, NBATCH = 2, SEQ = 8192, TOK = NBATCH * SEQ, DEPTH = 4;
constexpr int HD = 128, NQH = 8, NKVH = 2, KVW = NKVH * HD, WIN = 128;
constexpr int NIN = 5632;
constexpr int NEXP = 32, DEXP = 512, MOE_ROWS_MAX = 40960, MOE_TILES_MAX = 160;
constexpr float ALPHA = 1.6817928305074292f;
constexpr float LN_EPS = 1e-5f;
constexpr int CHUNK = 128, NCHUNK = SEQ / CHUNK;

__device__ __forceinline__ float bperm_f(int srclane, float v) { return __builtin_bit_cast(float, __builtin_amdgcn_ds_bpermute(srclane << 2, __builtin_bit_cast(int, v))); }

namespace pg8 {
#define PG8_LAS __attribute__((address_space(3)))
typedef unsigned short bf16_t;
typedef short bf16x8 __attribute__((ext_vector_type(8)));
typedef float f32x4 __attribute__((ext_vector_type(4)));
typedef unsigned u32x4 __attribute__((ext_vector_type(4)));
constexpr int BM = 256, BK = 64, HALF = 128, HTB = HALF * BK * 2  , STAGE_BYTES = 8 * HTB, NXCD = 8, WGM = 8;

__host__ __device__ __forceinline__ int lds_byte(int r, int c) { const int st = (r >> 4) * 2 + (c >> 5), rr = r & 15, cc = c & 31, ob = rr * 64 + cc * 2; return st * 1024 + (ob ^ (((ob >> 9) & 1) << 5)); }
__host__ __device__ __forceinline__ void stage_rc(int b, int& R, int& C) { const int st = b / 1024, sb = b % 1024, swz = sb ^ (((sb >> 9) & 1) << 5); R = (st >> 1) * 16 + swz / 64; C = (st & 1) * 32 + (swz % 64) / 2; }
__host__ __device__ __forceinline__ int perm32(int rho) { const int n = rho >> 4, i = rho & 15; return 8 * (i >> 2) + 4 * n + (i & 3); }

struct Unit { int pm, pn; };
struct Gemm { const bf16_t* A; const bf16_t* Bt; int M, N, K; };

struct StaticOrder {
    int nM, nN, nwg, G, c;
    __host__ __device__ void init(int M, int N, int G_, int c_) { nM = M / BM; nN = N / BM; nwg = nM * nN; G = G_; c = c_; }
    __host__ __device__ bool next(int i, Unit& u) const {
        const long L = (long)i * G + c; if (L >= nwg) return false;
        int wgid = (int)L; { const int q = nwg / NXCD, r = nwg % NXCD, xcd = wgid % NXCD, off = wgid / NXCD; wgid = (xcd < r ? xcd * (q + 1) : r * (q + 1) + (xcd - r) * q) + off; }
        const int nig = WGM * nN, gid = wgid / nig, fm = gid * WGM, gsz = (nM - fm) < WGM ? (nM - fm) : WGM;
        u.pm = fm + ((wgid % nig) % gsz); u.pn = (wgid % nig) / gsz; return true;
    }
    __device__ __forceinline__ void a_ready(const Unit&) const {}
    __device__ __forceinline__ void done(const Unit&) const {}
};

__device__ __forceinline__ unsigned cvt_pk_bf16(float lo, float hi) { unsigned r; asm volatile("v_cvt_pk_bf16_f32 %0, %1, %2" : "=v"(r) : "v"(lo), "v"(hi)); return r; }
typedef float f32x2 __attribute__((ext_vector_type(2)));
__device__ __forceinline__ f32x2 gelu_pk(f32x2 v) {
    const f32x2 av = __builtin_elementwise_abs(v), d = av * 0.2316418882f + 1.0f;
    f32x2 t; t.x = __builtin_amdgcn_rcpf(d.x); t.y = __builtin_amdgcn_rcpf(d.y);
    f32x2 q = t * 0.5307027145f + (-0.7265760135f); q = q * t + 0.7107068705f; q = q * t + (-0.142248368f); q = q * t + 0.127414796f; q = q * t;
    const f32x2 s = (v * v) * (-0.72134752044f);
    f32x2 e; e.x = __builtin_amdgcn_exp2f(s.x); e.y = __builtin_amdgcn_exp2f(s.y);
    const f32x2 m = v * (q * e), r = v - m;
    f32x2 o; o.x = v.x < 0.f ? m.x : r.x; o.y = v.y < 0.f ? m.y : r.y; return o;
}

typedef unsigned u32x2 __attribute__((ext_vector_type(2)));
__device__ __forceinline__ float bf_lo(unsigned w) { return __builtin_bit_cast(float, w << 16); }
__device__ __forceinline__ float bf_hi(unsigned w) { return __builtin_bit_cast(float, w & 0xffff0000u); }
__device__ __forceinline__ float sigmoid_f(float x) { return __builtin_amdgcn_rcpf(1.0f + __builtin_amdgcn_exp2f(-1.4426950408889634f * x)); }
__device__ __forceinline__ float gelu_tanh_f(float x) { const float z2 = 1.5957691216057308f * (x + 0.044715f * x * x * x); return x * sigmoid_f(z2); }
__device__ __forceinline__ u32x4 pack8f(f32x4 a, f32x4 b) { u32x4 w; w.x = cvt_pk_bf16(a[0], a[1]); w.y = cvt_pk_bf16(a[2], a[3]); w.z = cvt_pk_bf16(b[0], b[1]); w.w = cvt_pk_bf16(b[2], b[3]); return w; }

struct EpiInProj {
    static constexpr bool PERM = true, AFTER_DRAIN = false;
    bf16_t *Q, *K, *V, *XR, *YG, *GA, *GR; const float* rcos; const float* rsin;
    __device__ __forceinline__ void operator()(const f32x4 (&acc)[2][2][4][2], const Unit& u, int wr, int wc, int fr, int fq) const {
        const int pn = u.pn, row0 = u.pm * BM + wr * 64 + fr, cl = wc * 32 + 8 * fq;
        if (pn < 5) {
            bf16_t* base = pn < 4 ? Q + pn * 256 : K; const int ld = pn < 4 ? 1024 : 256; const int d0 = 16 * wc + 4 * fq;
#pragma unroll
            for (int ai = 0; ai < 2; ++ai)
#pragma unroll
                for (int m = 0; m < 4; ++m) { const int row = row0 + ai * HALF + m * 16, t = row & 8191;
                    const f32x4 cs = *(const f32x4*)(rcos + t * 64 + d0), sn = *(const f32x4*)(rsin + t * 64 + d0);
#pragma unroll
                    for (int bj = 0; bj < 2; ++bj) { const f32x4 x1 = acc[ai][bj][m][0], x2 = acc[ai][bj][m][1];
                        const f32x4 o1 = x1 * cs - x2 * sn, o2 = x2 * cs + x1 * sn;
                        *(u32x4*)(base + (size_t)row * ld + bj * HALF + cl) = pack8f(o1, o2); } }
        } else {
            bf16_t* base; int ld = 1024, act = 0;
            if (pn == 5) { base = V; ld = 256; }
            else if (pn < 10) { base = XR + (pn - 6) * 256; }
            else if (pn < 14) { base = YG + (pn - 10) * 256; act = 1; }
            else if (pn < 18) { base = GA + (pn - 14) * 256; act = 2; }
            else { base = GR + (pn - 18) * 256; act = 2; }
#pragma unroll
            for (int ai = 0; ai < 2; ++ai)
#pragma unroll
                for (int m = 0; m < 4; ++m) { const int row = row0 + ai * HALF + m * 16;
#pragma unroll
                    for (int bj = 0; bj < 2; ++bj) { f32x4 v0 = acc[ai][bj][m][0], v1 = acc[ai][bj][m][1];
                        if (act == 1) {
#pragma unroll
                            for (int e = 0; e < 4; ++e) { v0[e] = gelu_tanh_f(v0[e]); v1[e] = gelu_tanh_f(v1[e]); } }
                        else if (act == 2) {
#pragma unroll
                            for (int e = 0; e < 4; ++e) { v0[e] = sigmoid_f(v0[e]); v1[e] = sigmoid_f(v1[e]); } }
                        *(u32x4*)(base + (size_t)row * ld + bj * HALF + cl) = pack8f(v0, v1); } }
        }
    }
};
struct EpiGate {
    static constexpr bool PERM = true, AFTER_DRAIN = false;
    const bf16_t* gate; const bf16_t* add; bf16_t* out;
    __device__ __forceinline__ void operator()(const f32x4 (&acc)[2][2][4][2], const Unit& u, int wr, int wc, int fr, int fq) const {
        const int row0 = u.pm * BM + wr * 64 + fr, col0 = u.pn * BM + wc * 32 + 8 * fq;
#pragma unroll
        for (int ai = 0; ai < 2; ++ai)
#pragma unroll
            for (int m = 0; m < 4; ++m) { const size_t ro = (size_t)(row0 + ai * HALF + m * 16) * 1024 + col0;
#pragma unroll
                for (int bj = 0; bj < 2; ++bj) { const u32x4 g = *(const u32x4*)(gate + ro + bj * HALF);
                    f32x4 v0 = acc[ai][bj][m][0], v1 = acc[ai][bj][m][1];
                    v0[0] *= bf_lo(g.x); v0[1] *= bf_hi(g.x); v0[2] *= bf_lo(g.y); v0[3] *= bf_hi(g.y);
                    v1[0] *= bf_lo(g.z); v1[1] *= bf_hi(g.z); v1[2] *= bf_lo(g.w); v1[3] *= bf_hi(g.w);
                    if (add) { const u32x4 a = *(const u32x4*)(add + ro + bj * HALF);
                        v0[0] += bf_lo(a.x); v0[1] += bf_hi(a.x); v0[2] += bf_lo(a.y); v0[3] += bf_hi(a.y);
                        v1[0] += bf_lo(a.z); v1[1] += bf_hi(a.z); v1[2] += bf_lo(a.w); v1[3] += bf_hi(a.w); }
                    *(u32x4*)(out + ro + bj * HALF) = pack8f(v0, v1); } }
    }
};
struct EpiResid {
    static constexpr bool PERM = false, AFTER_DRAIN = false;
    const float* xin; float* out; float alpha;
    __device__ __forceinline__ void operator()(const f32x4 (&acc)[2][2][4][2], const Unit& u, int wr, int wc, int fr, int fq) const {
        const int row0 = u.pm * BM + wr * 64 + fr, col0 = u.pn * BM + wc * 32 + 4 * fq;
#pragma unroll
        for (int ai = 0; ai < 2; ++ai)
#pragma unroll
            for (int m = 0; m < 4; ++m) { const size_t ro = (size_t)(row0 + ai * HALF + m * 16) * 1024 + col0;
#pragma unroll
                for (int bj = 0; bj < 2; ++bj)
#pragma unroll
                    for (int n = 0; n < 2; ++n) { const f32x4 xv = *(const f32x4*)(xin + ro + bj * HALF + n * 16);
                        *(f32x4*)(out + ro + bj * HALF + n * 16) = xv * alpha + acc[ai][bj][m][n]; } }
    }
};
struct EpiSwiGLU {
    static constexpr bool PERM = true, AFTER_DRAIN = false;
    bf16_t* hid;
    __device__ __forceinline__ void operator()(const f32x4 (&acc)[2][2][4][2], const Unit& u, int wr, int wc, int fr, int fq) const {
        const int row0 = u.pm * BM + wr * 64 + fr, col0 = (u.pn & 3) * 128 + wc * 32 + 8 * fq;
#pragma unroll
        for (int ai = 0; ai < 2; ++ai)
#pragma unroll
            for (int m = 0; m < 4; ++m) { f32x4 h0, h1;
#pragma unroll
                for (int e = 0; e < 4; ++e) { const float g0 = acc[ai][0][m][0][e], g1 = acc[ai][0][m][1][e];
                    h0[e] = g0 * sigmoid_f(g0) * acc[ai][1][m][0][e]; h1[e] = g1 * sigmoid_f(g1) * acc[ai][1][m][1][e]; }
                *(u32x4*)(hid + (size_t)(row0 + ai * HALF + m * 16) * 512 + col0) = pack8f(h0, h1); }
    }
};
struct EpiDown {
    static constexpr bool PERM = true, AFTER_DRAIN = false;
    const int* slot; const float* roww; bf16_t* yb;
    __device__ __forceinline__ void operator()(const f32x4 (&acc)[2][2][4][2], const Unit& u, int wr, int wc, int fr, int fq) const {
        const int row0 = u.pm * BM + wr * 64 + fr, col0 = (u.pn & 3) * 256 + wc * 32 + 8 * fq;
#pragma unroll
        for (int ai = 0; ai < 2; ++ai)
#pragma unroll
            for (int m = 0; m < 4; ++m) { const int row = row0 + ai * HALF + m * 16; const int s = slot[row]; const float w = roww[row];
                if (s >= 0) {
#pragma unroll
                    for (int bj = 0; bj < 2; ++bj) *(u32x4*)(yb + (size_t)s * 1024 + col0 + bj * HALF) = pack8f(acc[ai][bj][m][0] * w, acc[ai][bj][m][1] * w); } }
    }
};
struct PanelStats {
    unsigned* xbuf;
    unsigned* cnt;
    unsigned* tmo;
    int ntn; float eps;
    unsigned code;
    __device__ __forceinline__ bool run(const f32x4 (&v)[2][2][4][2], const Unit& u, int wr, int wc, int fr, int fq, PG8_LAS unsigned char* lds, int wid, int lane) const {
        typedef float f32x2v __attribute__((ext_vector_type(2)));
        PG8_LAS f32x2v* P = (PG8_LAS f32x2v*)lds;
        PG8_LAS f32x2v* S = (PG8_LAS f32x2v*)(lds + 8192);
        PG8_LAS unsigned* flag = (PG8_LAS unsigned*)(lds + 8192 + 2048);
#pragma unroll
        for (int ai = 0; ai < 2; ++ai)
#pragma unroll
            for (int m = 0; m < 4; ++m) {
                float s = 0.f;
#pragma unroll
                for (int bj = 0; bj < 2; ++bj)
#pragma unroll
                    for (int n = 0; n < 2; ++n) { const f32x4 x = v[ai][bj][m][n]; s += (x[0] + x[1]) + (x[2] + x[3]); }
                s += bperm_f(lane ^ 16, s); s += bperm_f(lane ^ 32, s);
                const float mw = s * (1.0f / 64.0f); float q = 0.f;
#pragma unroll
                for (int bj = 0; bj < 2; ++bj)
#pragma unroll
                    for (int n = 0; n < 2; ++n) { const f32x4 d = v[ai][bj][m][n] - mw; q += (d[0] * d[0] + d[1] * d[1]) + (d[2] * d[2] + d[3] * d[3]); }
                q += bperm_f(lane ^ 16, q); q += bperm_f(lane ^ 32, q);
                if (fq == 0) P[(ai * HALF + wr * 64 + m * 16 + fr) * 4 + wc] = (f32x2v){mw, q};
            }
        asm volatile("s_waitcnt lgkmcnt(0)" ::: "memory"); __builtin_amdgcn_s_barrier(); asm volatile("" ::: "memory");
        const int row = wid * 32 + (lane & 31);
        if (lane < 32) {
            const f32x2v a = P[row * 4 + 0], b = P[row * 4 + 1], c = P[row * 4 + 2], d = P[row * 4 + 3];
            const float mt = (a.x + b.x + c.x + d.x) * 0.25f;
            const float da = a.x - mt, db = b.x - mt, dc = c.x - mt, dd = d.x - mt;
            const float m2 = (a.y + b.y) + (c.y + d.y) + 64.0f * ((da * da + db * db) + (dc * dc + dd * dd));
            unsigned long long* slot = (unsigned long long*)xbuf + ((size_t)(u.pm * BM + row) * 4 + u.pn);
            __hip_atomic_store(slot, ((unsigned long long)__float_as_uint(m2) << 32) | __float_as_uint(mt), __ATOMIC_RELAXED, __HIP_MEMORY_SCOPE_AGENT);
        }
        asm volatile("s_waitcnt vmcnt(0)" ::: "memory");
        if (lane == 0) __hip_atomic_fetch_add(cnt + 64 * u.pm, 1u, __ATOMIC_RELAXED, __HIP_MEMORY_SCOPE_AGENT);
        if (wid == 0) {
            bool dead = false; const unsigned long long t0 = __builtin_amdgcn_s_memrealtime(); const unsigned want = 8u * (unsigned)ntn;
            for (;;) {
                if ((unsigned)__builtin_amdgcn_readfirstlane(__hip_atomic_load(cnt + 64 * u.pm, __ATOMIC_RELAXED, __HIP_MEMORY_SCOPE_AGENT)) >= want) break;
                if (__builtin_amdgcn_s_memrealtime() - t0 > 2000000ull) {
                    if (lane == 0) { unsigned expect = 0u; __hip_atomic_compare_exchange_strong(tmo + 1, &expect, code | (unsigned)(u.pm & 0xff), __ATOMIC_RELAXED, __ATOMIC_RELAXED, __HIP_MEMORY_SCOPE_AGENT);
                                     __hip_atomic_store(tmo, 1u, __ATOMIC_RELAXED, __HIP_MEMORY_SCOPE_AGENT); }
                    dead = true; break; }
                __builtin_amdgcn_s_sleep(2);
            }
            __builtin_amdgcn_fence(__ATOMIC_ACQUIRE, "agent");
            if (lane == 0) flag[0] = dead ? 1u : 0u;
        }
        asm volatile("s_waitcnt vmcnt(0) lgkmcnt(0)" ::: "memory"); __builtin_amdgcn_s_barrier(); asm volatile("" ::: "memory");
        const bool bad = flag[0] != 0u;
        if (lane < 32) {
            const unsigned long long* slot = (const unsigned long long*)xbuf + (size_t)(u.pm * BM + row) * 4; float mt[4], m2[4]; float ms = 0.f;
#pragma unroll
            for (int t = 0; t < 4; ++t) { if (t < ntn) { const unsigned long long w = __hip_atomic_load(slot + t, __ATOMIC_RELAXED, __HIP_MEMORY_SCOPE_AGENT); mt[t] = __uint_as_float((unsigned)w); m2[t] = __uint_as_float((unsigned)(w >> 32)); } else { mt[t] = 0.f; m2[t] = 0.f; } ms += mt[t]; }
            const float mean = ms / (float)ntn; float q = 0.f;
#pragma unroll
            for (int t = 0; t < 4; ++t) if (t < ntn) { const float dm = mt[t] - mean; q += m2[t] + 256.0f * dm * dm; }
            S[row] = (f32x2v){mean, 1.0f / sqrtf(q / (256.0f * (float)ntn) + eps)};
        }
        asm volatile("s_waitcnt lgkmcnt(0)" ::: "memory"); __builtin_amdgcn_s_barrier(); asm volatile("" ::: "memory");
        return bad;
    }
};
struct EpiLn1 {
    static constexpr bool PERM = false, AFTER_DRAIN = true;
    const float* xin; float* x1o; bf16_t* xb; const float* gam; const float* bet; PanelStats st; unsigned poison;
    static constexpr float alpha = 1.6817928305074292f;
    __device__ __forceinline__ void fused(f32x4 (&acc)[2][2][4][2], const Unit& u, int wr, int wc, int fr, int fq, PG8_LAS unsigned char* lds, int wid, int lane) const {
        typedef float f32x2v __attribute__((ext_vector_type(2)));
        const PG8_LAS f32x2v* S = (const PG8_LAS f32x2v*)(lds + 8192);
        const int col0 = u.pn * BM + wc * 32 + 4 * fq;
        const unsigned bo0 = (unsigned)((u.pm * BM + wr * 64 + fr) * 1024 + col0) * 4u;
        const char* xinb = (const char*)xin; char* x1b = (char*)x1o; char* xbb = (char*)xb;
#pragma unroll
        for (int ai = 0; ai < 2; ++ai)
#pragma unroll
            for (int m = 0; m < 4; ++m) { const unsigned bo = bo0 + (unsigned)((ai * HALF + m * 16) * 4096);
#pragma unroll
                for (int bj = 0; bj < 2; ++bj)
#pragma unroll
                    for (int n = 0; n < 2; ++n) acc[ai][bj][m][n] += *(const f32x4*)(xinb + bo + (bj * HALF + n * 16) * 4) * alpha;
                asm volatile("" : "+v"(acc[ai][0][m][0]), "+v"(acc[ai][0][m][1]), "+v"(acc[ai][1][m][0]), "+v"(acc[ai][1][m][1]));
                if (m & 1) asm volatile("" ::: "memory"); }
        const bool bad = st.run(acc, u, wr, wc, fr, fq, lds, wid, lane) || poison != 0u;
        const float qnan = __builtin_nanf("");
#pragma unroll
        for (int bj = 0; bj < 2; ++bj)
#pragma unroll
            for (int n = 0; n < 2; ++n) {
                const f32x4 gv = *(const f32x4*)(gam + col0 + bj * HALF + n * 16), bv = *(const f32x4*)(bet + col0 + bj * HALF + n * 16);
#pragma unroll
                for (int ai = 0; ai < 2; ++ai)
#pragma unroll
                    for (int m = 0; m < 4; ++m) { const int r = ai * HALF + wr * 64 + m * 16 + fr; const f32x2v sr = S[r];
                        const unsigned bo = bo0 + (unsigned)((ai * HALF + m * 16) * 4096 + (bj * HALF + n * 16) * 4);
                        f32x4 o = (acc[ai][bj][m][n] - sr.x) * sr.y * gv + bv;
                        if (bad) o = (f32x4){qnan, qnan, qnan, qnan};
                        *(f32x4*)(x1b + bo) = o;
                        u32x2 w; w.x = cvt_pk_bf16(o[0], o[1]); w.y = cvt_pk_bf16(o[2], o[3]); *(u32x2*)(xbb + (bo >> 1)) = w; }
                asm volatile("" ::: "memory"); }
    }
};
struct MoeOrder {
    const int* tile_e; int nunits, G, c;
    __device__ __forceinline__ bool next(int i, Unit& u) const {
        const int L = i * G + c; if (L >= nunits) return false;
        u.pm = L >> 2; u.pn = __builtin_amdgcn_readfirstlane(tile_e[L >> 2]) * 4 + (L & 3); return true;
    }
    __device__ __forceinline__ void a_ready(const Unit&) const {}
    __device__ __forceinline__ void done(const Unit&) const {}
};
template <class Epi, class Sched, bool ALIGN_EPI = false, bool SP2 = false>
__device__ __forceinline__ void gemm_phase(PG8_LAS unsigned char* lds, const Gemm g, const Sched& S, const Epi& E) {
    int tid_ = threadIdx.x; asm volatile("" : "+v"(tid_));
    const int tid = tid_, wid = __builtin_amdgcn_readfirstlane(tid >> 6), lane = tid & 63, wr = wid >> 2, wc = wid & 3, fr = lane & 15, fq = lane >> 4;
    const int K = g.K, nt = K / BK;
    unsigned voffA[2], voffB[2];
#pragma unroll
    for (int i = 0; i < 2; ++i) { int R, C; stage_rc(tid * 16 + i * 8192, R, C); const int Rb = Epi::PERM ? ((R & ~31) + perm32(R & 31)) : R;
        voffA[i] = (unsigned)(R * K + C) * 2u; voffB[i] = (unsigned)(Rb * K + C) * 2u; }
    const size_t kstep = (size_t)(BK * 2);
    const size_t hstep = (size_t)HALF * K * 2;
    const size_t tstep = 2 * hstep;
    const unsigned ldsw = (unsigned)wid * 1024u;
    const int aoff = lds_byte(wr * 64 + fr, fq * 8), boff = lds_byte(wc * 32 + fr, fq * 8);
#define PG8_SA(b, h) (((b) * 2 + (h)) * HTB)
#define PG8_SB(b, h) ((4 + (b) * 2 + (h)) * HTB)
#define PG8_STAGE(bufoff, gbase, voff) do { _Pragma("unroll") for (int _i = 0; _i < 2; ++_i) \
        __builtin_amdgcn_global_load_lds((const unsigned*)((const char*)(gbase) + (voff)[_i]), (PG8_LAS unsigned*)(lds + (bufoff) + ldsw + _i * 8192), 16, 0, 0); } while (0)
#define PG8_LDA(dst, b, h) do { _Pragma("unroll") for (int m = 0; m < 4; ++m) _Pragma("unroll") for (int k = 0; k < 2; ++k) dst[m][k] = *(const PG8_LAS bf16x8*)(lds + PG8_SA(b, h) + aoff + m * 2048 + k * 1024); } while (0)
#define PG8_LDB(dst, b, h) do { _Pragma("unroll") for (int n = 0; n < 2; ++n) _Pragma("unroll") for (int k = 0; k < 2; ++k) dst[n][k] = *(const PG8_LAS bf16x8*)(lds + PG8_SB(b, h) + boff + n * 2048 + k * 1024); } while (0)
#define PG8_MMA(ai, bj, At, Bt) do { __builtin_amdgcn_s_setprio(1); _Pragma("unroll") for (int m = 0; m < 4; ++m) _Pragma("unroll") for (int n = 0; n < 2; ++n) _Pragma("unroll") for (int k = 0; k < 2; ++k) \
        acc[ai][bj][m][n] = __builtin_amdgcn_mfma_f32_16x16x32_bf16(Bt[n][k], At[m][k], acc[ai][bj][m][n], 0, 0, 0); __builtin_amdgcn_s_setprio(0); } while (0)
#define PG8_WAIT_V(n) asm volatile("s_waitcnt vmcnt(" #n ")" ::: "memory")
#define PG8_WAIT_L(n) asm volatile("s_waitcnt lgkmcnt(" #n ")" ::: "memory")
#define PG8_BAR __builtin_amdgcn_s_barrier()
#define PG8_SCHED __builtin_amdgcn_sched_barrier(0)
    Unit cur, nxt; int ui = 0;
    if (!S.next(0, cur)) return;
    f32x4 acc[2][2][4][2];
#pragma unroll
    for (int a = 0; a < 2; ++a)
#pragma unroll
        for (int b = 0; b < 2; ++b)
#pragma unroll
            for (int m = 0; m < 4; ++m)
#pragma unroll
                for (int n = 0; n < 2; ++n) acc[a][b][m][n] = (f32x4){0.f, 0.f, 0.f, 0.f};
    bf16x8 At[4][2], B0[2][2], B1[2][2];
    const char* cA = (const char*)g.A + (size_t)cur.pm * tstep; const char* cB = (const char*)g.Bt + (size_t)cur.pn * tstep;
    S.a_ready(cur);
    if constexpr (SP2) {
        PG8_STAGE(PG8_SB(0, 0), cB, voffB); PG8_STAGE(PG8_SB(0, 1), cB + hstep, voffB); PG8_STAGE(PG8_SA(0, 0), cA, voffA); PG8_STAGE(PG8_SA(0, 1), cA + hstep, voffA);
        if (wr == 1) PG8_BAR;
        PG8_WAIT_V(2); PG8_BAR;
        PG8_STAGE(PG8_SB(1, 0), cB + kstep, voffB); PG8_STAGE(PG8_SA(1, 0), cA + kstep, voffA); PG8_STAGE(PG8_SB(1, 1), cB + hstep + kstep, voffB);
        PG8_WAIT_V(6); PG8_BAR;
    } else {
        PG8_STAGE(PG8_SB(0, 0), cB, voffB); PG8_STAGE(PG8_SA(0, 0), cA, voffA); PG8_STAGE(PG8_SB(0, 1), cB + hstep, voffB); PG8_STAGE(PG8_SA(0, 1), cA + hstep, voffA);
        if (wr == 1) PG8_BAR;
        PG8_WAIT_V(4); PG8_BAR;
        PG8_STAGE(PG8_SB(1, 0), cB + kstep, voffB); PG8_STAGE(PG8_SA(1, 0), cA + kstep, voffA); PG8_STAGE(PG8_SB(1, 1), cB + hstep + kstep, voffB);
        PG8_WAIT_V(6); PG8_BAR;
    }
    for (;;) {
        const bool has_next = S.next(ui + 1, nxt);
        const char* nA = has_next ? (const char*)g.A + (size_t)nxt.pm * tstep : cA; const char* nB = has_next ? (const char*)g.Bt + (size_t)nxt.pn * tstep : cB;
        for (int t = 0; t < nt; t += 2) {
            const bool last = (t == nt - 2);
            const char* a1 = cA + (size_t)(t + 1) * kstep;
            const char* a2 = last ? nA : cA + (size_t)(t + 2) * kstep; const char* b2 = last ? nB : cB + (size_t)(t + 2) * kstep;
            const char* a3 = a2 + kstep; const char* b3 = b2 + kstep;
            if (last && has_next) S.a_ready(nxt);
            if constexpr (SP2) {
            PG8_LDB(B0, 0, 0); PG8_LDB(B1, 0, 1); PG8_SCHED; PG8_LDA(At, 0, 0); PG8_STAGE(PG8_SA(1, 1), a1 + hstep, voffA);
            PG8_WAIT_V(8); PG8_WAIT_L(0); PG8_BAR; PG8_MMA(0, 0, At, B0); PG8_MMA(0, 1, At, B1); PG8_BAR; PG8_SCHED;
            PG8_LDA(At, 0, 1); PG8_STAGE(PG8_SB(0, 0), b2, voffB); PG8_STAGE(PG8_SB(0, 1), b2 + hstep, voffB); PG8_STAGE(PG8_SA(0, 0), a2, voffA);
            PG8_WAIT_V(8); PG8_WAIT_L(0); PG8_BAR; PG8_MMA(1, 0, At, B0); PG8_MMA(1, 1, At, B1); PG8_BAR; PG8_SCHED;
            PG8_LDB(B0, 1, 0); PG8_LDB(B1, 1, 1); PG8_SCHED; PG8_LDA(At, 1, 0); PG8_STAGE(PG8_SA(0, 1), a2 + hstep, voffA);
            PG8_WAIT_V(8); PG8_WAIT_L(0); PG8_BAR; PG8_MMA(0, 0, At, B0); PG8_MMA(0, 1, At, B1); PG8_BAR; PG8_SCHED;
            PG8_LDA(At, 1, 1); PG8_STAGE(PG8_SB(1, 0), b3, voffB); PG8_STAGE(PG8_SB(1, 1), b3 + hstep, voffB); PG8_STAGE(PG8_SA(1, 0), a3, voffA);
            PG8_WAIT_V(8); PG8_WAIT_L(0); PG8_BAR; PG8_MMA(1, 0, At, B0); PG8_MMA(1, 1, At, B1); PG8_BAR; PG8_SCHED;
            } else {
            PG8_LDB(B0, 0, 0); PG8_SCHED; PG8_LDA(At, 0, 0); PG8_STAGE(PG8_SA(1, 1), a1 + hstep, voffA);
            PG8_WAIT_L(8); PG8_BAR; PG8_WAIT_L(0); PG8_MMA(0, 0, At, B0); PG8_BAR; PG8_SCHED;
            PG8_LDB(B1, 0, 1); PG8_STAGE(PG8_SB(0, 0), b2, voffB);
            PG8_BAR; PG8_WAIT_L(0); PG8_MMA(0, 1, At, B1); PG8_BAR;
            PG8_LDA(At, 0, 1); PG8_STAGE(PG8_SA(0, 0), a2, voffA);
            PG8_BAR; PG8_WAIT_L(0); PG8_MMA(1, 0, At, B0); PG8_BAR; PG8_SCHED;
            PG8_STAGE(PG8_SB(0, 1), b2 + hstep, voffB);
            PG8_WAIT_V(6); PG8_BAR; PG8_MMA(1, 1, At, B1); PG8_BAR;
            PG8_LDB(B0, 1, 0); PG8_SCHED; PG8_LDA(At, 1, 0); PG8_STAGE(PG8_SA(0, 1), a2 + hstep, voffA);
            PG8_WAIT_L(8); PG8_BAR; PG8_WAIT_L(0); PG8_MMA(0, 0, At, B0); PG8_BAR; PG8_SCHED;
            PG8_LDB(B1, 1, 1); PG8_STAGE(PG8_SB(1, 0), b3, voffB);
            PG8_BAR; PG8_WAIT_L(0); PG8_MMA(0, 1, At, B1); PG8_BAR;
            PG8_LDA(At, 1, 1); PG8_STAGE(PG8_SA(1, 0), a3, voffA);
            PG8_BAR; PG8_WAIT_L(0); PG8_MMA(1, 0, At, B0); PG8_BAR; PG8_SCHED;
            PG8_STAGE(PG8_SB(1, 1), b3 + hstep, voffB);
            PG8_WAIT_V(6); PG8_BAR; PG8_MMA(1, 1, At, B1); PG8_BAR;
            }
        }
        if constexpr (ALIGN_EPI) { if (wr == 0) PG8_BAR; }
        if constexpr (!Epi::AFTER_DRAIN) { E(acc, cur, wr, wc, fr, fq); S.done(cur); }
        if (!has_next) break;
#pragma unroll
        for (int a = 0; a < 2; ++a)
#pragma unroll
            for (int b = 0; b < 2; ++b)
#pragma unroll
                for (int m = 0; m < 4; ++m)
#pragma unroll
                    for (int n = 0; n < 2; ++n) acc[a][b][m][n] = (f32x4){0.f, 0.f, 0.f, 0.f};
        cur = nxt; cA = nA; cB = nB; ++ui;
        if constexpr (ALIGN_EPI) { if (wr == 1) PG8_BAR; }
    }
    PG8_WAIT_V(0);
    if constexpr (!ALIGN_EPI) { if (wr == 0) PG8_BAR; }
    PG8_BAR;
    if constexpr (Epi::AFTER_DRAIN) { E.fused(acc, cur, wr, wc, fr, fq, lds, wid, lane); S.done(cur); }
#undef PG8_SA
#undef PG8_SB
#undef PG8_STAGE
#undef PG8_LDA
#undef PG8_LDB
#undef PG8_MMA
#undef PG8_WAIT_V
#undef PG8_WAIT_L
#undef PG8_BAR
#undef PG8_SCHED
}
}
namespace attn {
constexpr int D = 128, QS = 1024, KVS = 256, OS = 1024;
constexpr float THR = 8.f;
constexpr bool WSKIP = true;
constexpr float SCALE = 0.08838834764831845f;
constexpr int NW = 8, QBLK = 32, KVBLK = 64, QB = NW * QBLK;
constexpr int SHM_V = KVBLK * D * 2, SHM_K = KVBLK * D * 2;
constexpr int LDS_BYTES = 2 * SHM_V + 2 * SHM_K + NW * 64 * 4;
using bf16 = __hip_bfloat16;
typedef short bf16x8 __attribute__((ext_vector_type(8)));
typedef short s16x4 __attribute__((ext_vector_type(4)));
typedef float f32x16 __attribute__((ext_vector_type(16)));
typedef float f32x4 __attribute__((ext_vector_type(4)));
typedef unsigned u32x4 __attribute__((ext_vector_type(4)));
template <class A, class Bt> struct same_t { static constexpr bool v = false; };
template <class A> struct same_t<A, A> { static constexpr bool v = true; };

#define KSWZ(row, colB) ((row) * 256 + ((colB) ^ (((row) & 7) << 4)))
#define SBAR() __builtin_amdgcn_sched_barrier(0)
__device__ __forceinline__ int v_st(int k, int c) { const int kk = (k & ~0xC) | ((k & 4) << 1) | ((k & 8) >> 1); return ((kk >> 3) * 4 + (c >> 5)) * 512 + ((kk & 7) * 32 + (c & 31)) * 2; }
__device__ __forceinline__ int v_rd_base(int lane) { return ((lane & 3) << 3) | (((lane >> 2) & 3) << 6) | (((lane >> 4) & 1) << 5) | (((lane >> 5) & 1) << 8); }
constexpr int v_rd_off(int d0, int ks, int half) { return d0 * 512 + ks * 4096 + half * 2048; }
__device__ __forceinline__ int crow(int r, int hi) { return (r & 3) + 8 * (r >> 2) + 4 * hi; }
__device__ __forceinline__ unsigned cvtpk(float lo, float hi) {
    unsigned r; asm volatile("v_cvt_pk_bf16_f32 %0, %1, %2" : "=v"(r) : "v"(lo), "v"(hi)); return r;
}
__device__ __forceinline__ bf16x8 pack8(f32x4 a, f32x4 b) {
    u32x4 w = {cvtpk(a[0], a[1]), cvtpk(a[2], a[3]), cvtpk(b[0], b[1]), cvtpk(b[2], b[3])};
    return *reinterpret_cast<bf16x8*>(&w);
}
template <class T> __device__ __forceinline__ bf16x8 load8(const T* p) {
    if constexpr (same_t<T, float>::v) { return pack8(*(const f32x4*)p, *(const f32x4*)(p + 4)); }
    else { return *reinterpret_cast<const bf16x8*>(p); }
}
__device__ __forceinline__ void mask_tile(f32x16& p0, f32x16& p1, int dq, unsigned W) {
    const float NEG = -__builtin_inff();
#pragma unroll
    for (int r = 0; r < 16; ++r) {
        const int c = (r & 3) + 8 * (r >> 2);
        if ((unsigned)(dq - c) >= W) p0[r] = NEG;
        if ((unsigned)(dq - c - 32) >= W) p1[r] = NEG;
    }
}
__device__ __forceinline__ void partialSM(f32x16& p0, f32x16& p1, float& m_reg, float& mn, float& alpha) {
    float pmax = p0[0]; for (int r = 1; r < 16; ++r) pmax = fmaxf(pmax, p0[r]); for (int r = 0; r < 16; ++r) pmax = fmaxf(pmax, p1[r]);
    { auto rr = __builtin_amdgcn_permlane32_swap(__float_as_uint(pmax), __float_as_uint(pmax), false, false);
      pmax = fmaxf(__uint_as_float(rr[0]), __uint_as_float(rr[1])); }
    constexpr float C2 = 1.4426950408889634f * SCALE;
    if (__builtin_expect(__all((pmax - m_reg) * SCALE <= THR), 1)) { mn = m_reg; alpha = 1.f; }
    else { mn = fmaxf(m_reg, pmax); alpha = __builtin_amdgcn_exp2f((m_reg - mn) * C2); m_reg = mn; }
    const float mnL = -mn * C2;
    for (int r = 0; r < 16; ++r) p0[r] = fmaf(p0[r], C2, mnL); for (int r = 0; r < 16; ++r) p1[r] = fmaf(p1[r], C2, mnL);
    for (int r = 0; r < 16; ++r) p0[r] = __builtin_amdgcn_exp2f(p0[r]);
}
__device__ __forceinline__ void finishSM(f32x16& p0, f32x16& p1, float alpha, float& l_reg, bf16x8& pa0, bf16x8& pa1, bf16x8& pa2, bf16x8& pa3) {
    for (int r = 0; r < 16; ++r) p1[r] = __builtin_amdgcn_exp2f(p1[r]);
    float ps = 0; for (int r = 0; r < 16; ++r) ps += p0[r]; for (int r = 0; r < 16; ++r) ps += p1[r];
    { auto rr = __builtin_amdgcn_permlane32_swap(__float_as_uint(ps), __float_as_uint(ps), false, false);
      ps = __uint_as_float(rr[0]) + __uint_as_float(rr[1]); }
    l_reg = l_reg * alpha + ps;
#define PK4(P, B_, OUT) do { unsigned a0 = cvtpk(P[B_+0], P[B_+1]), a1 = cvtpk(P[B_+2], P[B_+3]);                          \
        unsigned b0 = cvtpk(P[B_+4], P[B_+5]), b1 = cvtpk(P[B_+6], P[B_+7]);                                             \
        auto r0 = __builtin_amdgcn_permlane32_swap(a0, b0, false, false); auto r1 = __builtin_amdgcn_permlane32_swap(a1, b1, false, false); \
        u32x4 w = {r0[0], r1[0], r0[1], r1[1]}; OUT = *reinterpret_cast<bf16x8*>(&w); } while (0)
    PK4(p0, 0, pa0); PK4(p0, 8, pa1); PK4(p1, 0, pa2); PK4(p1, 8, pa3);
#undef PK4
}
template <int KB, bool SK>
__device__ __forceinline__ void qkt(f32x16& p0, f32x16& p1, const char* K_lds, int r32, int hi, const bf16x8* qr, bool act) {
    if (SK && !act) { const float NEG = -__builtin_inff();
#pragma unroll
        for (int r = 0; r < 16; ++r) { p0[r] = NEG; p1[r] = NEG; } return; }
    p0 = f32x16{}; p1 = f32x16{};
    const char* kb[4];
#pragma unroll
    for (int dd = 0; dd < 4; ++dd) kb[dd] = K_lds + KB * SHM_K + KSWZ(r32, (dd * 16 + hi * 8) * 2);
#pragma unroll
    for (int d0 = 0; d0 < 8; ++d0) { const char* a = kb[d0 & 3] + (d0 >> 2) * 128;
        bf16x8 b0 = *reinterpret_cast<const bf16x8*>(a);
        bf16x8 b1 = *reinterpret_cast<const bf16x8*>(a + 32 * 256);
        p0 = __builtin_amdgcn_mfma_f32_32x32x16_bf16(b0, qr[d0], p0, 0, 0, 0);
        p1 = __builtin_amdgcn_mfma_f32_32x32x16_bf16(b1, qr[d0], p1, 0, 0, 0); }
}
template <int VB, bool SK>
__device__ __forceinline__ void pv_tile(f32x16* o, int vb0, bf16x8 pa0, bf16x8 pa1, bf16x8 pa2, bf16x8 pa3, bool act) {
    if (SK && !act) return;
#define TRRD(dst, off) asm volatile("ds_read_b64_tr_b16 %0, %1 offset:%2" : "=&v"(dst) : "v"(vb0), "i"(off) : "memory")
#define PV_D0(d0) do { s16x4 l0, l1, l2, l3, h0, h1, h2, h3; constexpr int b_ = VB * SHM_V + v_rd_off(d0, 0, 0);     \
        TRRD(l0, b_); TRRD(h0, b_ + 2048); TRRD(l1, b_ + 4096); TRRD(h1, b_ + 6144); TRRD(l2, b_ + 8192); TRRD(h2, b_ + 10240); TRRD(l3, b_ + 12288); TRRD(h3, b_ + 14336); \
        asm volatile("s_waitcnt lgkmcnt(0)" ::: "memory"); SBAR();                 \
        o[d0] = __builtin_amdgcn_mfma_f32_32x32x16_bf16(pa0, (bf16x8){l0[0], l0[1], l0[2], l0[3], h0[0], h0[1], h0[2], h0[3]}, o[d0], 0, 0, 0);   \
        o[d0] = __builtin_amdgcn_mfma_f32_32x32x16_bf16(pa1, (bf16x8){l1[0], l1[1], l1[2], l1[3], h1[0], h1[1], h1[2], h1[3]}, o[d0], 0, 0, 0);   \
        o[d0] = __builtin_amdgcn_mfma_f32_32x32x16_bf16(pa2, (bf16x8){l2[0], l2[1], l2[2], l2[3], h2[0], h2[1], h2[2], h2[3]}, o[d0], 0, 0, 0);   \
        o[d0] = __builtin_amdgcn_mfma_f32_32x32x16_bf16(pa3, (bf16x8){l3[0], l3[1], l3[2], l3[3], h3[0], h3[1], h3[2], h3[3]}, o[d0], 0, 0, 0); } while (0)
    PV_D0(0); PV_D0(1); PV_D0(2); PV_D0(3);
#undef PV_D0
#undef TRRD
}

template <class TIn, class TOut> struct BlockRef { const TIn* Q; const TIn* K; const TIn* V; TOut* O; int P0; float sinkl2; };
template <class TIn> struct Seam {
    bf16x8 qr[8];
    bf16x8 st_v0, st_v1, st_k0, st_k1; f32x4 sf0, sf1, sf2, sf3;
    f32x4 tq[16];
};
__device__ __forceinline__ int swa_jlo(int P0, int W) { const int lowk = P0 - W; return lowk > 0 ? lowk / KVBLK : 0; }
#define ROW(p, k0, rr) ((p) + (size_t)((k0) + (rr)) * KVS + sc)
#define VMW() asm volatile("s_waitcnt vmcnt(0)" ::: "memory")
#define VMWN(n) asm volatile("s_waitcnt vmcnt(%0)" :: "i"(n) : "memory")
#define SLOAD_H(Kp, Vp, k0) do { S.st_v0 = load8<TIn>(ROW(Vp, k0, sr)); S.st_v1 = load8<TIn>(ROW(Vp, k0, 32 + sr));              \
                         S.st_k0 = load8<TIn>(ROW(Kp, k0, sr)); S.st_k1 = load8<TIn>(ROW(Kp, k0, 32 + sr)); } while (0)
#define SWRITE_HK(bf) do { *(bf16x8*)(K_lds + (bf) * SHM_K + kws) = S.st_k0; *(bf16x8*)(K_lds + (bf) * SHM_K + kws + 32 * 256) = S.st_k1; } while (0)
#define SWRITE_HV(bf) do { *(bf16x8*)(V_lds + (bf) * SHM_V + vst0) = S.st_v0; *(bf16x8*)(V_lds + (bf) * SHM_V + vst1) = S.st_v1; } while (0)
#define SWRITE_H(bf) do { SWRITE_HV(bf); SWRITE_HK(bf); } while (0)
#define SLOAD_F(p, k0) do { S.sf0 = *(const f32x4*)ROW(p, k0, sr); S.sf1 = *(const f32x4*)(ROW(p, k0, sr) + 4);                \
                            S.sf2 = *(const f32x4*)ROW(p, k0, 32 + sr); S.sf3 = *(const f32x4*)(ROW(p, k0, 32 + sr) + 4); } while (0)
#define SWRITE_KF(bf) do { *(bf16x8*)(K_lds + (bf) * SHM_K + kws) = pack8(S.sf0, S.sf1); *(bf16x8*)(K_lds + (bf) * SHM_K + kws + 32 * 256) = pack8(S.sf2, S.sf3); } while (0)
#define SWRITE_VF(bf) do { *(bf16x8*)(V_lds + (bf) * SHM_V + vst0) = pack8(S.sf0, S.sf1); *(bf16x8*)(V_lds + (bf) * SHM_V + vst1) = pack8(S.sf2, S.sf3); } while (0)
template <class TIn, class TOut>
__device__ __forceinline__ void causal_swa_prime(const BlockRef<TIn, TOut>& cur, int W, char* lds, Seam<TIn>& S) {
    constexpr bool F32 = same_t<TIn, float>::v;
    int tid_ = threadIdx.x; asm volatile("" : "+v"(tid_));
    const int tid = tid_, wid = __builtin_amdgcn_readfirstlane(tid >> 6), lane = tid & 63, r32 = lane & 31, hi = lane >> 5;
    const int sr = tid >> 4, sc = (tid & 15) * 8, kws = KSWZ(sr, sc * 2); char* K_lds = lds + 2 * SHM_V;
    const int kb0 = swa_jlo(cur.P0, W) * KVBLK;
    for (int d0 = 0; d0 < 8; ++d0) S.qr[d0] = load8<TIn>(cur.Q + (size_t)(wid * QBLK + r32) * QS + d0 * 16 + hi * 8);
    if constexpr (F32) { SLOAD_F((const float*)cur.K, kb0); VMW(); SWRITE_KF(0); SBAR(); SLOAD_F((const float*)cur.V, kb0); }
    else { SLOAD_H(cur.K, cur.V, kb0); VMW(); SWRITE_HK(0); }
    __syncthreads();
}
template <class TIn, class TOut>
__device__ __forceinline__ void causal_swa_block(const BlockRef<TIn, TOut>& cur, const BlockRef<TIn, TOut>& nxt, int skv, int W, char* lds, Seam<TIn>& S) {
    constexpr bool F32 = same_t<TIn, float>::v;
    int tid_ = threadIdx.x; asm volatile("" : "+v"(tid_));
    const int tid = tid_, wid = __builtin_amdgcn_readfirstlane(tid >> 6), lane = tid & 63, r32 = lane & 31, hi = lane >> 5;
    const int j_lo = swa_jlo(cur.P0, W);
    int j_hi = (cur.P0 + QB - 1 + W) / KVBLK + 1; if (j_hi > skv / KVBLK) j_hi = skv / KVBLK;
    const int NT = j_hi - j_lo;
    const int kbn = swa_jlo(nxt.P0, W) * KVBLK;
    const int qlo = cur.P0 + wid * QBLK, qm = qlo + r32 - 4 * hi;
    char* V_lds = lds; char* K_lds = lds + 2 * SHM_V;
    float* ws = (float*)(lds + 2 * SHM_V + 2 * SHM_K) + wid * 64; float* li_l = ws, * al_l = ws + 32;
    float m_reg = -1e30f, l_reg = 0; f32x16 o[4] = {};
    const int sr = tid >> 4, sc = (tid & 15) * 8, vst0 = v_st(sr, sc), vst1 = v_st(32 + sr, sc), kws = KSWZ(sr, sc * 2);
    const int vb0 = (int)(uintptr_t)V_lds + v_rd_base(lane);
    const TIn* Kh = cur.K; const TIn* Vh = cur.V;
#define RESC(a) do { if (__any((a) < 1.f)) { if (hi == 0) al_l[r32] = (a); asm volatile("s_waitcnt lgkmcnt(0)" ::: "memory");              \
                     for (int d_ = 0; d_ < 4; ++d_) for (int r = 0; r < 16; ++r) o[d_][r] *= al_l[crow(r, hi)]; } } while (0)
#define KBASE(t) ((j_lo + (t)) * KVBLK)
#define ACT(t) (KBASE(t) <= qlo + QBLK - 1 + W && KBASE(t) + KVBLK - 1 >= qlo - W)
#define MASKT(P0_, P1_, t) do { const int kb_ = KBASE(t); if ((!SK || ACT(t)) && (kb_ + KVBLK - 1 > qlo + W || kb_ < qlo + QBLK - 1 - W)) mask_tile(P0_, P1_, qm - kb_ + W, (unsigned)(2 * W + 1)); } while (0)
    constexpr int NQL = F32 ? 16 : 8;
    constexpr bool SK = WSKIP && !F32;
#define SEAM_K0() do { VMWN(NQL); if constexpr (F32) { SWRITE_KF(0); SBAR(); SLOAD_F((const float*)nxt.V, kbn); } else { SWRITE_HK(0); } SBAR(); } while (0)
    f32x16 pA0, pA1, pB0, pB1; float mnA, mnB, alA, alB; bf16x8 pa0, pa1, pa2, pa3;
    if constexpr (F32) { VMW(); SWRITE_VF(0); SBAR(); } else { SWRITE_HV(0); SBAR(); }
    if (NT > 1) { if constexpr (F32) SLOAD_F((const float*)Kh, KBASE(1)); else SLOAD_H(Kh, Vh, KBASE(1)); }
    SBAR(); qkt<0, SK>(pA0, pA1, K_lds, r32, hi, S.qr, ACT(0));
    if constexpr (F32) { if (NT > 1) { VMW(); SWRITE_KF(1); SBAR(); SLOAD_F((const float*)Vh, KBASE(1)); } }
    MASKT(pA0, pA1, 0); partialSM(pA0, pA1, m_reg, mnA, alA);
    if (NT > 1) { VMW(); if constexpr (F32) { SWRITE_VF(1); SBAR(); if (NT > 2) SLOAD_F((const float*)Kh, KBASE(2)); } else SWRITE_H(1); }
    __syncthreads();
#define HALF_STEP(PX0, PX1, mnX, alX, PY0, PY1, alY, t, KB, VB, SB) do {                                                      \
        SBAR(); qkt<KB, SK>(PX0, PX1, K_lds, r32, hi, S.qr, ACT(t));                                             \
        finishSM(PY0, PY1, alY, l_reg, pa0, pa1, pa2, pa3); SBAR();                                                           \
        if ((t) + 1 < NT) { if constexpr (F32) { VMW(); SWRITE_KF(SB); SBAR(); SLOAD_F((const float*)Vh, KBASE((t) + 1)); }  \
                            else { SLOAD_H(Kh, Vh, KBASE((t) + 1)); } SBAR(); }                                               \
        pv_tile<VB, SK>(o, vb0, pa0, pa1, pa2, pa3, ACT((t) - 1)); MASKT(PX0, PX1, (t)); partialSM(PX0, PX1, m_reg, mnX, alX);                                        \
        __syncthreads();                                                                                                      \
        if ((t) + 1 < NT) { VMW(); if constexpr (F32) { SWRITE_VF(SB); SBAR(); if ((t) + 2 < NT) SLOAD_F((const float*)Kh, KBASE((t) + 2)); } \
                            else { SWRITE_H(SB); } }                                                                          \
        RESC(alX); __syncthreads(); } while (0)
    for (int t = 1; t + 1 < NT; t += 2) {
        HALF_STEP(pB0, pB1, mnB, alB, pA0, pA1, alA, t, 1, 0, 0);
        HALF_STEP(pA0, pA1, mnA, alA, pB0, pB1, alB, t + 1, 0, 1, 1);
    }
    const bool even = (NT & 1) == 0;
    if (even) { SBAR(); qkt<1, SK>(pB0, pB1, K_lds, r32, hi, S.qr, ACT(NT - 1)); SBAR(); }
#define QROW(e) (nxt.Q + (size_t)(wid * QBLK + r32) * QS + ((e) >> 1) * 16 + hi * 8 + ((e) & 1) * 4)
    if constexpr (F32) { SLOAD_F((const float*)nxt.K, kbn); SBAR();
#pragma unroll
        for (int e = 0; e < 8; ++e) S.tq[e] = *(const f32x4*)QROW(e); }
    else { SLOAD_H(nxt.K, nxt.V, kbn); SBAR();
#pragma unroll
        for (int d0 = 0; d0 < 8; ++d0) S.qr[d0] = load8<TIn>(nxt.Q + (size_t)(wid * QBLK + r32) * QS + d0 * 16 + hi * 8); }
    SBAR();
    finishSM(pA0, pA1, alA, l_reg, pa0, pa1, pa2, pa3); SBAR();
    if constexpr (F32) {
#pragma unroll
        for (int e = 8; e < 16; ++e) S.tq[e] = *(const f32x4*)QROW(e); SBAR(); }
#undef QROW
    pv_tile<0, SK>(o, vb0, pa0, pa1, pa2, pa3, ACT(even ? NT - 2 : NT - 1));
    if (even) { MASKT(pB0, pB1, NT - 1); partialSM(pB0, pB1, m_reg, mnB, alB); __syncthreads(); RESC(alB);
        finishSM(pB0, pB1, alB, l_reg, pa0, pa1, pa2, pa3); SBAR(); pv_tile<1, SK>(o, vb0, pa0, pa1, pa2, pa3, ACT(NT - 1)); }
    SBAR(); SEAM_K0();
    l_reg += __builtin_amdgcn_exp2f(cur.sinkl2 - m_reg * (1.4426950408889634f * SCALE));
    if (hi == 0) li_l[r32] = l_reg; asm volatile("s_waitcnt lgkmcnt(0)" ::: "memory");
    float rli[16];
#pragma unroll
    for (int r = 0; r < 16; ++r) rli[r] = __builtin_amdgcn_rcpf(li_l[crow(r, hi)]);
    TOut* Ow = cur.O + (size_t)(wid * QBLK) * OS;
#pragma unroll
    for (int r = 0; r < 16; ++r) { const int orow = crow(r, hi);
#pragma unroll
        for (int d0 = 0; d0 < 4; ++d0) { const float v = o[d0][r] * rli[r];
            if constexpr (same_t<TOut, float>::v) { Ow[(size_t)orow * OS + d0 * 32 + r32] = v; }
            else { const float vn = bperm_f(lane ^ 1, v);
                   if ((r32 & 1) == 0) *(unsigned*)(Ow + (size_t)orow * OS + d0 * 32 + r32) = cvtpk(v, vn); } } }
    if constexpr (F32) {
#pragma unroll
        for (int d0 = 0; d0 < 8; ++d0) S.qr[d0] = pack8(S.tq[2 * d0], S.tq[2 * d0 + 1]); }
    __syncthreads();
#undef RESC
#undef KBASE
#undef ACT
#undef MASKT
#undef SEAM_K0
#undef HALF_STEP
}
#undef ROW
#undef VMW
#undef VMWN
#undef SLOAD_H
#undef SWRITE_HK
#undef SWRITE_HV
#undef SWRITE_H
#undef SLOAD_F
#undef SWRITE_KF
#undef SWRITE_VF


}
#undef KSWZ
#undef SBAR

constexpr int NWAVES = 8, NTHREADS = NWAVES * 64;
constexpr size_t MiB = 1u << 20;
constexpr size_t WS_CTL = 0, CTL_ZERO_BYTES = 1 * MiB;
constexpr size_t WS_WIN = 2 * MiB;
constexpr size_t WS_WAO = 46 * MiB, WS_WRO = 54 * MiB, WS_WOUT = 62 * MiB;
constexpr size_t WS_WG = 70 * MiB;
constexpr size_t WS_WR = 74 * MiB;
constexpr size_t WS_RCOS = 75 * MiB, WS_RSIN = 77 * MiB;
constexpr size_t WS_SP = 79 * MiB;
constexpr size_t WS_ROUTE = 80 * MiB;
constexpr size_t WS_SUMM = 82 * MiB;
constexpr size_t WS_XBUF = 86 * MiB;
constexpr size_t WS_WGU = 96 * MiB;
constexpr size_t WS_WD = 352 * MiB;
constexpr size_t WS_XB = 480 * MiB;
constexpr size_t WS_X1 = 512 * MiB;
constexpr size_t WS_XRES = 576 * MiB;
constexpr size_t WS_Q = 640 * MiB, WS_K = 672 * MiB, WS_V = 680 * MiB, WS_XR = 688 * MiB, WS_YG = 720 * MiB, WS_GA = 752 * MiB, WS_GR = 784 * MiB;
constexpr size_t WS_AO = 816 * MiB, WS_HG = 848 * MiB, WS_YA = 880 * MiB, WS_MG = 912 * MiB, WS_SS = 944 * MiB, WS_END = 976 * MiB;
constexpr size_t WS_XS = 640 * MiB;
constexpr size_t WS_HID = 720 * MiB;
constexpr size_t WS_YB = 760 * MiB;
constexpr size_t RT_TOKE = 0, RT_TOKPOS = 131072, RT_TOKW = 262144, RT_SLOT = 393216, RT_ROWW = 557056, RT_TILEE = 720896, RT_BLKCNT = 786432;
constexpr int CW_BAR = 4096;
constexpr int CW_CNT = 16384;
constexpr int CW_SEAM = 32768;

constexpr int LDS_BYTES = 147456;

#define GAS __attribute__((address_space(1)))
#define LAS __attribute__((address_space(3)))
typedef unsigned short bf16raw;
typedef unsigned v4u __attribute__((ext_vector_type(4)));
typedef unsigned v2u __attribute__((ext_vector_type(2)));
typedef float f32x4 __attribute__((ext_vector_type(4)));
typedef float f32x2 __attribute__((ext_vector_type(2)));
typedef short bf16x8 __attribute__((ext_vector_type(8)));
#define LDS_WAIT() asm volatile("s_waitcnt lgkmcnt(0)" ::: "memory")
__device__ __forceinline__ unsigned f2bf(float f) { unsigned u = __builtin_bit_cast(unsigned, f); return (u + 0x7fffu + ((u >> 16) & 1u)) >> 16; }
__device__ __forceinline__ unsigned pk2(float lo, float hi) { return f2bf(lo) | (f2bf(hi) << 16); }
__device__ __forceinline__ float bflo(unsigned w) { return __builtin_bit_cast(float, w << 16); }
__device__ __forceinline__ float bfhi(unsigned w) { return __builtin_bit_cast(float, w & 0xffff0000u); }
template <int CTRL, int ROWMASK> __device__ __forceinline__ float dpp_f(float v) { return __builtin_bit_cast(float, __builtin_amdgcn_update_dpp(0, __builtin_bit_cast(int, v), CTRL, ROWMASK, 0xF, false)); }
__device__ __forceinline__ float wave_sum(float v) {
    v += dpp_f<0xB1, 0xF>(v);
    v += dpp_f<0x4E, 0xF>(v);
    v += dpp_f<0x141, 0xF>(v);
    v += dpp_f<0x140, 0xF>(v);
    v += dpp_f<0x142, 0xA>(v);
    v += dpp_f<0x143, 0xC>(v);
    return __builtin_bit_cast(float, __builtin_amdgcn_readlane(__builtin_bit_cast(int, v), 63));
}

#define XB_TMO      128
#define XB_XCNT(j)  (256  + 64 * (j))
#define XB_XSUB(j)  (1280 + 64 * (j))
#define XB_XGEN(j)  (2304 + 64 * (j))
#define XB_TOP      3328
#define XB_TOPGEN   3392
#define XCD_BAR_WORDS 3456
#define XB_SPIN_CAP (1u << 18)

__device__ __forceinline__ unsigned xb_ld(unsigned* p)              { return __hip_atomic_load(p, __ATOMIC_RELAXED, __HIP_MEMORY_SCOPE_AGENT); }
__device__ __forceinline__ unsigned xb_add(unsigned* p, unsigned v) { return __hip_atomic_fetch_add(p, v, __ATOMIC_RELAXED, __HIP_MEMORY_SCOPE_AGENT); }
__device__ __forceinline__ unsigned xb_xcc_id() { return (unsigned)__builtin_amdgcn_s_getreg((3 << 11) | 20) & 0xFu; }
#define XB_SPIN(cond, bar) do { unsigned _sp = 0; while (cond) { __builtin_amdgcn_s_sleep(1); \
    if ((++_sp & 255u) == 0u) { if (xb_ld(&(bar)[XB_TMO])) break; if (_sp > XB_SPIN_CAP) { atomicAdd(&(bar)[XB_TMO], 1u); break; } } } } while (0)

struct XcdBarrier {
    unsigned* bar; unsigned x;
    volatile LAS unsigned* st;
};

__device__ __forceinline__ XcdBarrier xcd_barrier_post(unsigned* bar, volatile LAS unsigned* st) {
    XcdBarrier b; b.bar = bar; b.x = xb_xcc_id(); b.st = st;
    if (threadIdx.x == 0) (void)xb_add(&bar[XB_XCNT(b.x)], 1u);
    return b;
}
__device__ __forceinline__ void xcd_barrier_complete(unsigned* bar, unsigned x, unsigned& nloc, unsigned& nx) {
    const unsigned G = gridDim.x * gridDim.y * gridDim.z;
    unsigned sum, cnt, mine, sp = 0u;
    for (;;) {
        sum = 0u; cnt = 0u; mine = 0u;
#pragma unroll
        for (unsigned j = 0; j < 16; ++j) { const unsigned c = xb_ld(&bar[XB_XCNT(j)]); sum += c; cnt += (c > 0u) ? 1u : 0u; mine = (j == x) ? c : mine; }
        if (sum == G) break;
        __builtin_amdgcn_s_sleep(1);
        if ((++sp & 255u) == 0u) { if (xb_ld(&bar[XB_TMO])) break; if (sp > XB_SPIN_CAP) { atomicAdd(&bar[XB_TMO], 1u); break; } }
    }
    nloc = mine > 0u ? mine : 1u; nx = cnt > 0u ? cnt : 1u;
}

__device__ __forceinline__ void xcd_barrier(const XcdBarrier& b) {
    asm volatile("s_waitcnt vmcnt(0)" ::: "memory");
    __syncthreads();
    if (threadIdx.x == 0) {
        unsigned* bar = b.bar;
        __builtin_amdgcn_s_waitcnt(0);
        unsigned nloc = b.st[0], nx = b.st[1];
        if (nloc == 0u) { xcd_barrier_complete(bar, b.x, nloc, nx); b.st[0] = nloc; b.st[1] = nx; }
        const unsigned old = xb_add(&bar[XB_XSUB(b.x)], 1u);
        const unsigned gen = old / nloc;
        if (old + 1u == (gen + 1u) * nloc) {
            __builtin_amdgcn_fence(__ATOMIC_RELEASE, "agent");
            asm volatile("s_waitcnt vmcnt(0)" ::: "memory");
            const unsigned og = xb_add(&bar[XB_TOP], 1u);
            const unsigned tg = og / nx;
            if (og + 1u == (tg + 1u) * nx) xb_add(&bar[XB_TOPGEN], 1u);
            else XB_SPIN(xb_ld(&bar[XB_TOPGEN]) == tg, bar);
            __builtin_amdgcn_fence(__ATOMIC_ACQUIRE, "agent");
            xb_add(&bar[XB_XGEN(b.x)], 1u);
            asm volatile("s_waitcnt vmcnt(0)" ::: "memory");
        } else {
            XB_SPIN(xb_ld(&bar[XB_XGEN(b.x)]) == gen, bar);
            __builtin_amdgcn_fence(__ATOMIC_ACQUIRE, "agent");
            asm volatile("s_waitcnt vmcnt(0)" ::: "memory");
        }
    }
    __syncthreads();
}
template <int MAP> __device__ __forceinline__ int dest_row(int n, int aux) {
    if (MAP == 1) { if (n >= 1280) return n; const int hb = n & ~127, d = n & 127, dd = d & 63; return hb + 32 * (dd >> 4) + 8 * ((dd >> 2) & 3) + 4 * (d >> 6) + (dd & 3); }
    if (MAP == 2) return 256 * (n >> 7) + 128 * aux + (n & 127);
    return n;
}
struct TItem { const float* W; bf16raw* WT; int K, N, map, aux, k0, n0; float scale; };
__device__ __forceinline__ int dest_row_rt(int map, int n, int aux) { return map == 1 ? dest_row<1>(n, aux) : (map == 2 ? dest_row<2>(n, aux) : n); }
__device__ __forceinline__ void titem_load(const TItem& I, float (&t)[32], int lane) {
#pragma unroll
    for (int i = 0; i < 32; ++i) { const int kk = 2 * i + (lane >> 5); t[i] = __builtin_nontemporal_load(I.W + (size_t)(I.k0 + kk) * I.N + I.n0 + (lane & 31)); }
}
__device__ __forceinline__ void titem_store(const TItem& I, const float (&t)[32], LAS float* scr, int lane) {
#pragma unroll
    for (int i = 0; i < 32; ++i) { const int kk = 2 * i + (lane >> 5); scr[kk * 33 + (lane & 31)] = t[i] * I.scale; }
    LDS_WAIT(); asm volatile("" ::: "memory");
    const int c = lane & 7;
#pragma unroll
    for (int j = 0; j < 4; ++j) { const int n = (lane >> 3) + 8 * j; const LAS float* s = scr + (8 * c) * 33 + n;
        v4u o; o.x = pk2(s[0 * 33], s[1 * 33]); o.y = pk2(s[2 * 33], s[3 * 33]); o.z = pk2(s[4 * 33], s[5 * 33]); o.w = pk2(s[6 * 33], s[7 * 33]);
        *(v4u*)(I.WT + (size_t)dest_row_rt(I.map, I.n0 + n, I.aux) * I.K + I.k0 + 8 * c) = o; }
    LDS_WAIT(); asm volatile("" ::: "memory");
}
struct Ptrs {
    const float* in[22]; float* out; unsigned char* ws;
};
constexpr int PI_IN = 16 * (NIN / 32), PI_SQ = 16 * 32, PI_G = 2 * 4, PI_E = 16 * 16;
constexpr int PN_IN = DEPTH * PI_IN, PN_SQ = DEPTH * PI_SQ, PN_G = DEPTH * 16 * PI_G, PN_E = DEPTH * NEXP * PI_E;
constexpr int P_NITEMS = PN_IN + 3 * PN_SQ + 2 * PN_G + 3 * PN_E;
struct TSrc { const float *w_in, *w_rec, *w_ing, *w_ao, *w_ro, *w_out, *w_eg, *w_eu, *w_ed; unsigned char* ws; };
__device__ __forceinline__ TItem titem_decode(const TSrc& P, int it) {
    TItem I; I.map = 0; I.aux = 0; I.scale = 1.f; int r = it, item;
    if (r < PN_IN) { const int l = r / PI_IN; I.W = P.w_in + (size_t)l * DM * NIN; I.K = DM; I.N = NIN; I.WT = (bf16raw*)(P.ws + WS_WIN) + (size_t)l * NIN * DM; I.map = 1; item = r % PI_IN; }
    else if ((r -= PN_IN) < PN_SQ) { const int l = r / PI_SQ; I.W = P.w_ao + (size_t)l * DM * DM; I.K = DM; I.N = DM; I.WT = (bf16raw*)(P.ws + WS_WAO) + (size_t)l * DM * DM; item = r % PI_SQ; }
    else if ((r -= PN_SQ) < PN_SQ) { const int l = r / PI_SQ; I.W = P.w_ro + (size_t)l * DM * DM; I.K = DM; I.N = DM; I.WT = (bf16raw*)(P.ws + WS_WRO) + (size_t)l * DM * DM; item = r % PI_SQ; }
    else if ((r -= PN_SQ) < PN_SQ) { const int l = r / PI_SQ; I.W = P.w_out + (size_t)l * DM * DM; I.K = DM; I.N = DM; I.WT = (bf16raw*)(P.ws + WS_WOUT) + (size_t)l * DM * DM; item = r % PI_SQ; }
    else if ((r -= PN_SQ) < 2 * PN_G) { const int gate = r >= PN_G ? 1 : 0; r -= gate * PN_G; const int mat = r / PI_G;
        const int l = mat >> 4, dir = (mat >> 3) & 1, n = mat & 7;
        if (gate) I.W = P.w_ing + (size_t)mat * 16384; else I.W = P.w_rec + (size_t)mat * 16384;
        I.K = 128; I.N = 128; I.WT = (bf16raw*)(P.ws + WS_WG) + ((size_t)((l * 2 + dir) * 2 + gate) * 8 + n) * 16384; I.scale = -1.4426950408889634f; item = r % PI_G; }
    else if ((r -= 2 * PN_G) < PN_E) { const int le = r / PI_E; I.W = P.w_eg + (size_t)le * DM * DEXP; I.K = DM; I.N = DEXP; I.WT = (bf16raw*)(P.ws + WS_WGU) + (size_t)le * 1024 * DM; I.map = 2; I.aux = 0; item = r % PI_E; }
    else if ((r -= PN_E) < PN_E) { const int le = r / PI_E; I.W = P.w_eu + (size_t)le * DM * DEXP; I.K = DM; I.N = DEXP; I.WT = (bf16raw*)(P.ws + WS_WGU) + (size_t)le * 1024 * DM; I.map = 2; I.aux = 1; item = r % PI_E; }
    else { r -= PN_E; const int le = r / PI_E; I.W = P.w_ed + (size_t)le * DEXP * DM; I.K = DEXP; I.N = DM; I.WT = (bf16raw*)(P.ws + WS_WD) + (size_t)le * DM * DEXP; item = r % PI_E; }
    const int nblk = I.N / 32; I.k0 = 64 * (item / nblk); I.n0 = 32 * (item % nblk);
    return I;
}
__device__ __forceinline__ void p0_prologue(const Ptrs& P, LAS unsigned char* lds, int vcu, int G, int wave, int lane) {
    LAS float* scr = (LAS float*)(lds + wave * 16384);
    const int gw = vcu * NWAVES + wave, NGW = G * NWAVES;
    {
        const TSrc TS{P.in[1], P.in[5], P.in[7], P.in[10], P.in[11], P.in[12], P.in[19], P.in[20], P.in[21], P.ws};
        int it = gw;
        if (it < P_NITEMS) {
            TItem cur = titem_decode(TS, it); float t[32]; titem_load(cur, t, lane);
#pragma unroll 1
            for (;;) {
                const int itn = it + NGW; const bool more = itn < P_NITEMS;
                const TItem nxt = titem_decode(TS, more ? itn : it); float tn[32];
                titem_load(nxt, tn, lane);
                titem_store(cur, t, scr, lane);
                if (!more) break;
                cur = nxt; it = itn;
#pragma unroll
                for (int i = 0; i < 32; ++i) t[i] = tn[i];
            }
        }
    }
    const int gt = gw * 64 + lane, NGT = NGW * 64;
    float* rc = (float*)(P.ws + WS_RCOS); float* rs = (float*)(P.ws + WS_RSIN);
    for (int i = gt; i < SEQ * 64; i += NGT) { const int t = i >> 6, f = i & 63;
        const float inv = (float)pow(10000.0, -(double)f / 64.0); const float ang = (float)t * inv;
        rc[i] = (float)cos((double)ang); rs[i] = (float)sin((double)ang); }
    float* sp = (float*)(P.ws + WS_SP);
    for (int i = gt; i < DEPTH * 2 * 1024; i += NGT) { const double lam = (double)P.in[9][i]; sp[i] = (float)(8.0 * log1p(exp(-lam))); }
    bf16raw* wrh = (bf16raw*)(P.ws + WS_WR); bf16raw* wrl = wrh + (size_t)DEPTH * 48 * 1024;
    for (int i = gt; i < DEPTH * 48 * 1024; i += NGT) { const int l = i / (48 * 1024), o = (i / 1024) % 48, k = i & 1023;
        const float w = o < 4 ? P.in[15][((size_t)l * 1024 + k) * 4 + o] : (o < 36 ? P.in[17][((size_t)l * 1024 + k) * 32 + (o - 4)] : 0.f);
        const unsigned h = f2bf(w); wrh[i] = (bf16raw)h; wrl[i] = (bf16raw)f2bf(w - __builtin_bit_cast(float, h << 16)); }
    bf16raw* XB = (bf16raw*)(P.ws + WS_XB);
    for (int i = gt; i < TOK * DM / 8; i += NGT) { const f32x4 a = *(const f32x4*)(P.in[0] + (size_t)i * 8), b = *(const f32x4*)(P.in[0] + (size_t)i * 8 + 4);
        v4u o; o.x = pk2(a[0], a[1]); o.y = pk2(a[2], a[3]); o.z = pk2(b[0], b[1]); o.w = pk2(b[2], b[3]); *(v4u*)(XB + (size_t)i * 8) = o; }
}

constexpr int XC_LD = 272;
constexpr int SCAN_XC = 0, SCAN_OUT = 128 * XC_LD, OUT_LD = 528;
typedef float f32x4s __attribute__((ext_vector_type(4)));
__device__ __forceinline__ int xc_off(int row, int chunk) { return row * XC_LD + (((chunk + 4 * (row >> 4)) & 15) << 4); }
constexpr int SCAN_CW = SCAN_OUT + 128 * OUT_LD;
constexpr int LDS_CARRY = 131072 + 1024;
__device__ __forceinline__ void carry_prep(const Ptrs& P, LAS unsigned char* lds, int vcu, int G, int tid) {
    const f32x2* SUMM = (const f32x2*)(P.ws + WS_SUMM);
#pragma unroll 1
    for (int k2 = 0; k2 < 2; ++k2) {
        const int idx = tid + NTHREADS * k2, ui = idx >> 8, dir = (idx >> 7) & 1, chn = idx & 127;
        const int id = vcu + G * ui, b = id >> 9, ch = (id >> 3) & 63, n = id & 7, gc = n * 128 + chn;
        const int nlist = dir == 0 ? ch : (NCHUNK - 1 - ch);
        const f32x2* base = SUMM + ((size_t)((b * 2 + dir) * NCHUNK)) * 1024 + gc;
        float carry = 0.f;
#pragma unroll 1
        for (int i0 = 0; i0 < nlist; i0 += 16) {
            f32x2 s[16];
#pragma unroll
            for (int i = 0; i < 16; ++i) { const int ii = i0 + i; const int ic = ii < NCHUNK ? ii : NCHUNK - 1; const int c2 = dir == 0 ? ic : (NCHUNK - 1 - ic); s[i] = base[(size_t)c2 * 1024]; }
#pragma unroll
            for (int i = 0; i < 16; ++i) { if (i0 + i < nlist) carry = s[i].x * carry + s[i].y; }
        }
        ((LAS float*)(lds + LDS_CARRY))[idx] = carry;
    }
}
template <bool PASS2>
__device__ __forceinline__ void scan_phase(const Ptrs& P, LAS unsigned char* lds, int l, int vcu, int G, int tid, int wave, int lane) {
    const bf16raw* XR = (const bf16raw*)(P.ws + WS_XR);
    const int n = vcu & 7;
    const int col = lane & 15, q = lane >> 4, dcol = 16 * wave + col, gc = n * 128 + dcol;
    const int cg = tid & 15, tl = tid >> 4, c0 = n * 128 + cg * 8;
    if (tid < 160) { const int g2 = tid / 10, part = tid % 10;
        const float* src = part < 8 ? P.in[3] + (size_t)l * 4 * 1024 + (part >> 1) * 1024 + n * 128 + g2 * 8 + (part & 1) * 4 : P.in[4] + (size_t)l * 1024 + n * 128 + g2 * 8 + (part & 1) * 4;
        *(LAS f32x4*)(lds + SCAN_CW + (g2 * 40 + part * 4) * 4) = *(const f32x4*)src; }
    const bf16raw* WG = (const bf16raw*)(P.ws + WS_WG);
    bf16x8 Bf[2][2][4];
    float br[2], bi[2], nsp2[2];
#pragma unroll
    for (int dir = 0; dir < 2; ++dir) {
#pragma unroll
        for (int gate = 0; gate < 2; ++gate)
#pragma unroll
            for (int ks = 0; ks < 4; ++ks) Bf[dir][gate][ks] = *(const bf16x8*)(WG + (((size_t)((l * 2 + dir) * 2 + gate) * 8 + n) * 128 + dcol) * 128 + 32 * ks + 8 * q);
        br[dir] = -1.4426950408889634f * P.in[6][(size_t)(l * 2 + dir) * 1024 + gc]; bi[dir] = -1.4426950408889634f * P.in[8][(size_t)(l * 2 + dir) * 1024 + gc];
        nsp2[dir] = -1.4426950408889634f * ((const float*)(P.ws + WS_SP))[(size_t)(l * 2 + dir) * 1024 + gc];
    }
    bf16x8 Bsel;
    { const int jt = 16 * (wave & 1) + col - 8 * q; v4u w;
      w.x = (jt == 0 ? 0x3F80u : 0u) | (jt == 1 ? 0x3F800000u : 0u); w.y = (jt == 2 ? 0x3F80u : 0u) | (jt == 3 ? 0x3F800000u : 0u);
      w.z = (jt == 4 ? 0x3F80u : 0u) | (jt == 5 ? 0x3F800000u : 0u); w.w = (jt == 6 ? 0x3F80u : 0u) | (jt == 7 ? 0x3F800000u : 0u);
      Bsel = __builtin_bit_cast(bf16x8, w); }
    const int wsel = wave >> 1;
    v4u xraw[7];
#define SCAN_LOAD_ROWS(unit_id) do { const int b_ = (unit_id) >> 9, t0_ = (((unit_id) >> 3) & 63) * CHUNK; _Pragma("unroll") for (int i = 0; i < 7; ++i) { const int t = t0_ + 4 * tl - 2 + i; const int tc = t < 0 ? 0 : (t >= SEQ ? SEQ - 1 : t); \
        v4u raw_ = *(const v4u*)(XR + ((size_t)(b_ * SEQ + tc)) * 1024 + c0); if (t != tc) raw_ = (v4u){0u, 0u, 0u, 0u}; xraw[i] = raw_; } } while (0)
    SCAN_LOAD_ROWS(vcu);
    __syncthreads();
#pragma unroll 1
    for (int k = 0; k < 4; ++k) {
        const int id = vcu + G * k, b = id >> 9, ch = (id >> 3) & 63, t0 = ch * CHUNK;
        v4u ygv[4];
        {
            float w[4][8], bb[8];
            const LAS f32x4* cw = (const LAS f32x4*)(lds + SCAN_CW + cg * 160);
#pragma unroll
            for (int tap = 0; tap < 4; ++tap) { const f32x4 a = cw[2 * tap], c = cw[2 * tap + 1];
                w[tap][0] = a[0]; w[tap][1] = a[1]; w[tap][2] = a[2]; w[tap][3] = a[3]; w[tap][4] = c[0]; w[tap][5] = c[1]; w[tap][6] = c[2]; w[tap][7] = c[3]; }
            { const f32x4 a = cw[8], c = cw[9]; bb[0] = a[0]; bb[1] = a[1]; bb[2] = a[2]; bb[3] = a[3]; bb[4] = c[0]; bb[5] = c[1]; bb[6] = c[2]; bb[7] = c[3]; }
            float xv[7][8];
#pragma unroll
            for (int i = 0; i < 7; ++i) { const v4u raw = xraw[i];
                xv[i][0] = bflo(raw.x); xv[i][1] = bfhi(raw.x); xv[i][2] = bflo(raw.y); xv[i][3] = bfhi(raw.y); xv[i][4] = bflo(raw.z); xv[i][5] = bfhi(raw.z); xv[i][6] = bflo(raw.w); xv[i][7] = bfhi(raw.w); }
#pragma unroll
            for (int j = 0; j < 4; ++j) { float o[8];
#pragma unroll
                for (int e = 0; e < 8; ++e) o[e] = bb[e] + w[0][e] * xv[j][e] + w[1][e] * xv[j + 1][e] + w[2][e] * xv[j + 2][e] + w[3][e] * xv[j + 3][e];
                v4u pk; pk.x = pk2(o[0], o[1]); pk.y = pk2(o[2], o[3]); pk.z = pk2(o[4], o[5]); pk.w = pk2(o[6], o[7]);
                *(LAS v4u*)(lds + SCAN_XC + xc_off(4 * tl + j, cg)) = pk; }
        }
        __syncthreads();
        if (k + 1 < 4) SCAN_LOAD_ROWS(vcu + G * (k + 1));
#pragma unroll
        for (int dir = 0; dir < 2; ++dir) {
            float carry = 0.f, atot = 1.f, prun = 1.f;
            const float cdir = PASS2 ? ((const LAS float*)(lds + LDS_CARRY))[(k * 2 + dir) * 128 + dcol] : 0.f;
#pragma unroll 1
            for (int hh = 0; hh < 2; ++hh) {
                const int tb = 64 * (dir == 0 ? hh : 1 - hh);
                float e1[16], e2[16], xq[16];
#pragma unroll
                for (int i = 0; i < 4; ++i) {
                    const int row = tb + 16 * (col >> 2) + 4 * i + (col & 3);
                    f32x4s accr = {br[dir], br[dir], br[dir], br[dir]}, acci = {bi[dir], bi[dir], bi[dir], bi[dir]}, accx = {0.f, 0.f, 0.f, 0.f};
#pragma unroll
                    for (int ks = 0; ks < 4; ++ks) { const bf16x8 a = *(const LAS bf16x8*)(lds + SCAN_XC + xc_off(row, 4 * ks + q));
                        accr = __builtin_amdgcn_mfma_f32_16x16x32_bf16(a, Bf[dir][0][ks], accr, 0, 0, 0);
                        if (!PASS2) acci = __builtin_amdgcn_mfma_f32_16x16x32_bf16(a, Bf[dir][1][ks], acci, 0, 0, 0); }
                    if (!PASS2) { const bf16x8 a = *(const LAS bf16x8*)(lds + SCAN_XC + xc_off(row, 4 * wsel + q)); accx = __builtin_amdgcn_mfma_f32_16x16x32_bf16(a, Bsel, accx, 0, 0, 0); }
#pragma unroll
                    for (int j = 0; j < 4; ++j) { e1[4 * i + j] = accr[j]; e2[4 * i + j] = acci[j]; xq[4 * i + j] = accx[j]; }
                }
                float av[16], uv[16];
#pragma unroll
                for (int t = 0; t < 16; ++t) { e1[t] = __builtin_amdgcn_exp2f(e1[t]); if (!PASS2) e2[t] = __builtin_amdgcn_exp2f(e2[t]); }
#pragma unroll
                for (int t = 0; t < 16; ++t) { e1[t] = __builtin_amdgcn_rcpf(1.f + e1[t]); if (!PASS2) e2[t] = __builtin_amdgcn_rcpf(1.f + e2[t]); }
#pragma unroll
                for (int t = 0; t < 16; ++t) av[t] = __builtin_amdgcn_exp2f(nsp2[dir] * e1[t]);
                if (!PASS2) {
#pragma unroll
                    for (int t = 0; t < 16; ++t) uv[t] = xq[t] * e2[t] * __builtin_amdgcn_sqrtf(__builtin_fmaf(-av[t], av[t], 1.f));
                }
                float Pc[16], Sc[16];
                if (dir == 0) { Pc[0] = av[0]; if (!PASS2) Sc[0] = uv[0];
#pragma unroll
                    for (int t = 1; t < 16; ++t) { Pc[t] = Pc[t - 1] * av[t]; if (!PASS2) Sc[t] = av[t] * Sc[t - 1] + uv[t]; } }
                else { Pc[15] = av[15]; if (!PASS2) Sc[15] = uv[15];
#pragma unroll
                    for (int t = 14; t >= 0; --t) { Pc[t] = Pc[t + 1] * av[t]; if (!PASS2) Sc[t] = av[t] * Sc[t + 1] + uv[t]; } }
                const float Pa = dir == 0 ? Pc[15] : Pc[0];
                if (!PASS2) {
                    const float Sa = dir == 0 ? Sc[15] : Sc[0];
                    float hs = carry, run = carry;
#pragma unroll
                    for (int k2 = 0; k2 < 4; ++k2) { const int qq = dir == 0 ? k2 : 3 - k2;
                        const float Ak = bperm_f(col + 16 * qq, Pa), Hk = bperm_f(col + 16 * qq, Sa);
                        if (qq == q) hs = run;
                        run = Ak * run + Hk; atot *= Ak; }
                    carry = run;
#pragma unroll
                    for (int t = 0; t < 16; ++t) { const float h = Sc[t] + Pc[t] * hs;
                        LAS float* op = (LAS float*)(lds + SCAN_OUT + (tb + 16 * q + t) * OUT_LD + dcol * 4);
                        if (dir == 0) *op = h; else *op = *op + h; }
                } else {
                    float pq = prun;
#pragma unroll
                    for (int k2 = 0; k2 < 4; ++k2) { const int qq = dir == 0 ? k2 : 3 - k2;
                        const float Ak = bperm_f(col + 16 * qq, Pa);
                        if (qq == q) pq = prun;
                        prun *= Ak; }
                    const float sc = pq * cdir;
#pragma unroll
                    for (int t = 0; t < 16; ++t) { const float h = Pc[t] * sc;
                        LAS float* op = (LAS float*)(lds + SCAN_OUT + (tb + 16 * q + t) * OUT_LD + dcol * 4);
                        if (dir == 0) *op = h; else *op = *op + h; }
                }
            }
            if (!PASS2) { if (q == 0) ((f32x2*)(P.ws + WS_SUMM))[((size_t)((b * 2 + dir) * NCHUNK + ch)) * 1024 + gc] = (f32x2){atot, carry}; }
        }
        if (!PASS2) {
            __syncthreads();
            bf16raw* SS = (bf16raw*)(P.ws + WS_SS);
#pragma unroll
            for (int j = 0; j < 4; ++j) { const int t = t0 + 4 * tl + j; const size_t go = ((size_t)(b * SEQ + t)) * 1024 + c0;
                const f32x4 h0 = *(const LAS f32x4*)(lds + SCAN_OUT + (4 * tl + j) * OUT_LD + cg * 32), h1 = *(const LAS f32x4*)(lds + SCAN_OUT + (4 * tl + j) * OUT_LD + cg * 32 + 16);
                v4u o; o.x = pk2(h0[0], h0[1]); o.y = pk2(h0[2], h0[3]); o.z = pk2(h1[0], h1[1]); o.w = pk2(h1[2], h1[3]);
                *(v4u*)(SS + go) = o; }
        } else {
            v4u ssv[4];
            { const bf16raw* YGp = (const bf16raw*)(P.ws + WS_YG); const bf16raw* SSp = (const bf16raw*)(P.ws + WS_SS);
#pragma unroll
              for (int j = 0; j < 4; ++j) { const size_t go = ((size_t)(b * SEQ + t0 + 4 * tl + j)) * 1024 + c0; ygv[j] = *(const v4u*)(YGp + go); ssv[j] = *(const v4u*)(SSp + go); } }
            __syncthreads();
            bf16raw* HG = (bf16raw*)(P.ws + WS_HG);
#pragma unroll
            for (int j = 0; j < 4; ++j) { const int t = t0 + 4 * tl + j; const size_t go = ((size_t)(b * SEQ + t)) * 1024 + c0;
                const f32x4 h0 = *(const LAS f32x4*)(lds + SCAN_OUT + (4 * tl + j) * OUT_LD + cg * 32), h1 = *(const LAS f32x4*)(lds + SCAN_OUT + (4 * tl + j) * OUT_LD + cg * 32 + 16); const v4u yv = ygv[j], sv = ssv[j];
                v4u o; o.x = pk2((h0[0] + bflo(sv.x)) * bflo(yv.x), (h0[1] + bfhi(sv.x)) * bfhi(yv.x)); o.y = pk2((h0[2] + bflo(sv.y)) * bflo(yv.y), (h0[3] + bfhi(sv.y)) * bfhi(yv.y));
                o.z = pk2((h1[0] + bflo(sv.z)) * bflo(yv.z), (h1[1] + bfhi(sv.z)) * bfhi(yv.z)); o.w = pk2((h1[2] + bflo(sv.w)) * bflo(yv.w), (h1[3] + bfhi(sv.w)) * bfhi(yv.w));
                *(v4u*)(HG + go) = o; }
        }
        __syncthreads();
    }
#undef SCAN_LOAD_ROWS
}

constexpr int RT_XH = 0, RT_XL = 65536;
constexpr int RT_PART = 0, RT_LOGIT = 49152;
__device__ __forceinline__ void ln1_router_phase(const Ptrs& P, LAS unsigned char* lds, int l, int vcu, int G, int tid, int wave, int lane) {
    const float* X1 = (const float*)(P.ws + WS_X1); float* X1O = P.out;
    bf16raw* XB = (bf16raw*)(P.ws + WS_XB);
    const float* gam = P.in[13] + (size_t)(l * 2 + 0) * 1024; const float* bet = P.in[14] + (size_t)(l * 2 + 0) * 1024;
    const bf16raw* WRH = (const bf16raw*)(P.ws + WS_WR) + (size_t)l * 48 * 1024; const bf16raw* WRL = WRH + (size_t)DEPTH * 48 * 1024;
    LAS int* lcnt = (LAS int*)(lds + LDS_CARRY);
    if (tid < NEXP) lcnt[tid] = 0;
    int* tok_e = (int*)(P.ws + WS_ROUTE + RT_TOKE); int* tok_pos = (int*)(P.ws + WS_ROUTE + RT_TOKPOS); float* tok_w = (float*)(P.ws + WS_ROUTE + RT_TOKW);
    f32x4 gv[4], bv[4];
#pragma unroll
    for (int j = 0; j < 4; ++j) { gv[j] = *(const f32x4*)(gam + 4 * lane + 256 * j); bv[j] = *(const f32x4*)(bet + 4 * lane + 256 * j); }
    const int col = lane & 15, q = lane >> 4;
#pragma unroll 1
    for (int pass = 0; pass < 2; ++pass) {
        const int mb = vcu * 64 + pass * 32;
#pragma unroll
        for (int r = 0; r < 4; ++r) {
            const int lr = wave * 4 + r; const size_t go = (size_t)(mb + lr) * 1024;
            f32x4 x[4]; float s = 0.f;
#pragma unroll
            for (int j = 0; j < 4; ++j) { x[j] = *(const f32x4*)(X1 + go + 4 * lane + 256 * j); s += (x[j][0] + x[j][1]) + (x[j][2] + x[j][3]); }
            const float mean = wave_sum(s) * (1.f / 1024.f); float s2 = 0.f;
#pragma unroll
            for (int j = 0; j < 4; ++j) { x[j] = x[j] - mean; s2 += (x[j][0] * x[j][0] + x[j][1] * x[j][1]) + (x[j][2] * x[j][2] + x[j][3] * x[j][3]); }
            const float rstd = 1.f / sqrtf(wave_sum(s2) * (1.f / 1024.f) + LN_EPS);
#pragma unroll
            for (int j = 0; j < 4; ++j) { x[j] = x[j] * rstd * gv[j] + bv[j];
                *(f32x4*)(X1O + go + 4 * lane + 256 * j) = x[j];
                const unsigned h0 = f2bf(x[j][0]), h1 = f2bf(x[j][1]), h2 = f2bf(x[j][2]), h3 = f2bf(x[j][3]);
                v2u hv; hv.x = h0 | (h1 << 16); hv.y = h2 | (h3 << 16);
                *(v2u*)(XB + go + 4 * lane + 256 * j) = hv;
                v2u lv; lv.x = pk2(x[j][0] - __builtin_bit_cast(float, h0 << 16), x[j][1] - __builtin_bit_cast(float, h1 << 16)); lv.y = pk2(x[j][2] - __builtin_bit_cast(float, h2 << 16), x[j][3] - __builtin_bit_cast(float, h3 << 16));
                const int off = lr * 2048 + (((32 * j + (lane >> 1)) ^ (lr & 15)) << 4) + (lane & 1) * 8;
                *(LAS v2u*)(lds + RT_XH + off) = hv; *(LAS v2u*)(lds + RT_XL + off) = lv; }
        }
        bf16x8 Bh[4][3], Bl[4][3];
#pragma unroll
        for (int ks = 0; ks < 4; ++ks)
#pragma unroll
            for (int nt = 0; nt < 3; ++nt) { const size_t wo = (size_t)(16 * nt + col) * 1024 + 32 * (wave * 4 + ks) + 8 * q;
                Bh[ks][nt] = *(const bf16x8*)(WRH + wo); Bl[ks][nt] = *(const bf16x8*)(WRL + wo); }
        __syncthreads();
        f32x4 acc[2][3];
#pragma unroll
        for (int m = 0; m < 2; ++m)
#pragma unroll
            for (int nt = 0; nt < 3; ++nt) acc[m][nt] = (f32x4){0.f, 0.f, 0.f, 0.f};
#pragma unroll
        for (int ks = 0; ks < 4; ++ks)
#pragma unroll
            for (int m = 0; m < 2; ++m) { const int row = 16 * m + col; const int off = row * 2048 + (((4 * (wave * 4 + ks) + q) ^ (row & 15)) << 4);
                const bf16x8 ah = *(const LAS bf16x8*)(lds + RT_XH + off), al = *(const LAS bf16x8*)(lds + RT_XL + off);
#pragma unroll
                for (int nt = 0; nt < 3; ++nt) { acc[m][nt] = __builtin_amdgcn_mfma_f32_16x16x32_bf16(ah, Bh[ks][nt], acc[m][nt], 0, 0, 0);
                    acc[m][nt] = __builtin_amdgcn_mfma_f32_16x16x32_bf16(al, Bh[ks][nt], acc[m][nt], 0, 0, 0);
                    acc[m][nt] = __builtin_amdgcn_mfma_f32_16x16x32_bf16(ah, Bl[ks][nt], acc[m][nt], 0, 0, 0); } }
        __syncthreads();
#pragma unroll
        for (int m = 0; m < 2; ++m)
#pragma unroll
            for (int nt = 0; nt < 3; ++nt) *(LAS f32x4*)(lds + RT_PART + ((wave * 6 + m * 3 + nt) * 256 + lane * 4) * 4) = acc[m][nt];
        __syncthreads();
#pragma unroll
        for (int i = 0; i < 3; ++i) { const int idx = tid + NTHREADS * i, t = idx >> 8, p = idx & 255; float s = 0.f;
#pragma unroll
            for (int w = 0; w < 8; ++w) s += *(const LAS float*)(lds + RT_PART + ((w * 6 + t) * 256 + p) * 4);
            const int ll = p >> 2, j = p & 3, token = 16 * (t / 3) + 4 * (ll >> 4) + j, o = 16 * (t % 3) + (ll & 15);
            const float bias = o < 4 ? P.in[16][l * 4 + o] : (o < 36 ? P.in[18][l * 32 + o - 4] : 0.f);
            *(LAS float*)(lds + RT_LOGIT + (token * 48 + o) * 4) = s + bias; }
        __syncthreads();
        if (tid < 32) {
            const LAS float* lg = (const LAS float*)(lds + RT_LOGIT + tid * 192);
            int gi = 0; float gm = lg[0];
#pragma unroll
            for (int k = 1; k < 4; ++k) { const float v = lg[k]; if (v > gm) { gm = v; gi = k; } }
            float den = 0.f;
#pragma unroll
            for (int k = 0; k < 4; ++k) den += expf(lg[k] - gm);
            const float gval = 1.f / den;
            const LAS float* eg = lg + 4 + 8 * gi;
            int i1 = 0; float v1 = eg[0];
#pragma unroll
            for (int k = 1; k < 8; ++k) { const float v = eg[k]; if (v > v1) { v1 = v; i1 = k; } }
            int i2 = -1; float v2 = 0.f;
#pragma unroll
            for (int k = 0; k < 8; ++k) { const float v = eg[k]; if (k != i1 && (i2 < 0 || v > v2)) { v2 = v; i2 = k; } }
            const float ex = expf(v2 - v1), w1 = gval / (1.f + ex), w2 = gval * ex / (1.f + ex);
            const int m = mb + tid, e1 = gi * 8 + i1, e2 = gi * 8 + i2;
            const int p1 = __hip_atomic_fetch_add(lcnt + e1, 1, __ATOMIC_RELAXED, __HIP_MEMORY_SCOPE_WORKGROUP), p2 = __hip_atomic_fetch_add(lcnt + e2, 1, __ATOMIC_RELAXED, __HIP_MEMORY_SCOPE_WORKGROUP);
            tok_e[2 * m] = e1; tok_pos[2 * m] = p1; tok_w[2 * m] = w1; tok_e[2 * m + 1] = e2; tok_pos[2 * m + 1] = p2; tok_w[2 * m + 1] = w2;
        }
        __syncthreads();
    }
    if (tid < NEXP) ((int*)(P.ws + WS_ROUTE + RT_BLKCNT))[vcu * NEXP + tid] = lcnt[tid];
    __syncthreads();
}
__device__ __forceinline__ void gather_phase(const Ptrs& P, LAS unsigned char* lds, int l, int vcu, int G, int tid, int wave, int lane) {
    LAS int* ps = (LAS int*)lds;
    const int* blkcnt = (const int*)(P.ws + WS_ROUTE + RT_BLKCNT);
    { const int e = tid & 31, part = tid >> 5; int tot = 0, pre = 0;
#pragma unroll
        for (int i = 0; i < 16; ++i) { const int b2 = part * 16 + i; const int c = blkcnt[b2 * NEXP + e]; tot += c; pre += b2 < vcu ? c : 0; }
        ps[256 + part * 32 + e] = tot; ps[768 + part * 32 + e] = pre; }
    __syncthreads();
    if (tid < NEXP) { int tot = 0, pre = 0;
#pragma unroll
        for (int p2 = 0; p2 < 16; ++p2) { tot += ps[256 + p2 * 32 + tid]; pre += ps[768 + p2 * 32 + tid]; }
        ps[64 + tid] = tot; ps[128 + tid] = pre; }
    __syncthreads();
    if (tid == 0) { int acc = 0; for (int e = 0; e < NEXP; ++e) { ps[e] = acc; acc += (ps[64 + e] + 255) & ~255; } ps[32] = acc; }
    __syncthreads();
    const int* tok_e = (const int*)(P.ws + WS_ROUTE + RT_TOKE); const int* tok_pos = (const int*)(P.ws + WS_ROUTE + RT_TOKPOS); const float* tok_w = (const float*)(P.ws + WS_ROUTE + RT_TOKW);
    int* slot = (int*)(P.ws + WS_ROUTE + RT_SLOT); float* roww = (float*)(P.ws + WS_ROUTE + RT_ROWW); int* tile_e = (int*)(P.ws + WS_ROUTE + RT_TILEE);
    const bf16raw* XB = (const bf16raw*)(P.ws + WS_XB); bf16raw* XS = (bf16raw*)(P.ws + WS_XS);
    for (int i = 0; i < 16; ++i) { const int a = vcu * 128 + wave * 16 + i;
        const int e = tok_e[a], dest = ps[e] + ps[128 + e] + tok_pos[a];
        const v4u* src = (const v4u*)(XB + (size_t)(a >> 1) * 1024); v4u* dst = (v4u*)(XS + (size_t)dest * 1024);
        const v4u a0 = src[lane], a1 = src[64 + lane]; dst[lane] = a0; dst[64 + lane] = a1;
        if (lane == 0) { slot[dest] = a; roww[dest] = tok_w[a]; }
    }
    const int total = ps[32];
    for (int r = (vcu * NTHREADS + tid); r < total; r += G * NTHREADS) {
        int e = 0;
#pragma unroll 1
        for (int k = 1; k < NEXP; ++k) if (r >= ps[k]) e = k;
        if (r - ps[e] >= ps[64 + e]) { slot[r] = -1; roww[r] = 0.f; }
    }
    if (vcu == 0) {
        const int nt = total >> 8;
        for (int t = tid; t < nt; t += NTHREADS) { int e = 0;
#pragma unroll 1
            for (int k = 1; k < NEXP; ++k) if (t * 256 >= ps[k]) e = k;
            tile_e[t] = e; }
        if (tid == 0) tile_e[MOE_TILES_MAX] = nt;
    }
    __syncthreads();
}
__device__ __forceinline__ void ln2_phase(const Ptrs& P, int l, float* dstf, bool use_moe, int vcu, int G, int wave, int lane) {
    const float* X1 = P.out; bf16raw* XB = (bf16raw*)(P.ws + WS_XB); const bf16raw* YB = (const bf16raw*)(P.ws + WS_YB);
    const float* gam = P.in[13] + (size_t)(l * 2 + 1) * 1024; const float* bet = P.in[14] + (size_t)(l * 2 + 1) * 1024;
    const int gw = vcu * NWAVES + wave, NGW = G * NWAVES;
    f32x4 gv[4], bv[4];
#pragma unroll
    for (int j = 0; j < 4; ++j) { gv[j] = *(const f32x4*)(gam + 4 * lane + 256 * j); bv[j] = *(const f32x4*)(bet + 4 * lane + 256 * j); }
    for (int m = gw; m < TOK; m += NGW) {
        f32x4 x[4]; float s = 0.f;
#pragma unroll
        for (int j = 0; j < 4; ++j) { x[j] = *(const f32x4*)(X1 + (size_t)m * 1024 + 4 * lane + 256 * j) * ALPHA;
            if (use_moe) { const v2u y0 = *(const v2u*)(YB + (size_t)(2 * m) * 1024 + 4 * lane + 256 * j), y1 = *(const v2u*)(YB + (size_t)(2 * m + 1) * 1024 + 4 * lane + 256 * j);
                x[j][0] += bflo(y0.x) + bflo(y1.x); x[j][1] += bfhi(y0.x) + bfhi(y1.x); x[j][2] += bflo(y0.y) + bflo(y1.y); x[j][3] += bfhi(y0.y) + bfhi(y1.y); }
            s += (x[j][0] + x[j][1]) + (x[j][2] + x[j][3]); }
        const float mean = wave_sum(s) * (1.f / 1024.f); float s2 = 0.f;
#pragma unroll
        for (int j = 0; j < 4; ++j) { x[j] = x[j] - mean; s2 += (x[j][0] * x[j][0] + x[j][1] * x[j][1]) + (x[j][2] * x[j][2] + x[j][3] * x[j][3]); }
        const float rstd = 1.f / sqrtf(wave_sum(s2) * (1.f / 1024.f) + LN_EPS);
#pragma unroll
        for (int j = 0; j < 4; ++j) { x[j] = x[j] * rstd * gv[j] + bv[j];
            *(f32x4*)(dstf + (size_t)m * 1024 + 4 * lane + 256 * j) = x[j];
            v2u o; o.x = pk2(x[j][0], x[j][1]); o.y = pk2(x[j][2], x[j][3]);
            *(v2u*)(XB + (size_t)m * 1024 + 4 * lane + 256 * j) = o; }
    }
}
__device__ __forceinline__ void resid_only_phase(const Ptrs& P, const float* xin, int vcu, int G, int wave, int lane) {
    float* X1 = (float*)(P.ws + WS_X1); const int gt = (vcu * NWAVES + wave) * 64 + lane, NGT = G * NTHREADS;
    for (int i = gt; i < TOK * DM / 4; i += NGT) *(f32x4*)(X1 + (size_t)i * 4) = *(const f32x4*)(xin + (size_t)i * 4) * ALPHA;
}

constexpr int N_PHASES = 1 + 10 * DEPTH;
#ifndef ONLY_S
#define ONLY_S -1
#endif
#define PH_ON(k) (ONLY_S < 0 || ONLY_S == (k))
#ifndef REP_MASK
#define REP_MASK 0
#endif
#define REPS(bit) (((REP_MASK >> (bit)) & 1) ? 2 : 1)
struct Args { const float* in[22]; float* out; unsigned char* ws; int ph_lo, ph_hi, sub, pad; };

__device__ __forceinline__ attn::BlockRef<attn::bf16, attn::bf16> attn_block(const Ptrs& P, int l, int id) {
    const int hq = id & 3, qb = (id >> 2) & 31, g = (id >> 7) & 1, b = id >> 8;
    attn::BlockRef<attn::bf16, attn::bf16> r;
    const size_t row0 = (size_t)b * SEQ + (size_t)qb * 256;
    r.Q = (const attn::bf16*)(P.ws + WS_Q) + row0 * 1024 + (g * 4 + hq) * 128;
    r.O = (attn::bf16*)(P.ws + WS_AO) + row0 * 1024 + (g * 4 + hq) * 128;
    r.K = (const attn::bf16*)(P.ws + WS_K) + (size_t)b * SEQ * 256 + g * 128;
    r.V = (const attn::bf16*)(P.ws + WS_V) + (size_t)b * SEQ * 256 + g * 128;
    r.P0 = qb * 256; r.sinkl2 = P.in[2][l * 8 + g * 4 + hq] * 1.4426950408889634f;
    return r;
}

__global__ void __launch_bounds__(NTHREADS, 2) fwd_kernel(Args args) {
    extern __shared__ __attribute__((aligned(16))) unsigned char lds_raw[];
    LAS unsigned char* lds = (LAS unsigned char*)lds_raw;
    const int tid0 = threadIdx.x;
    const int G = gridDim.x, bx = blockIdx.x, vcu = (G % 8 == 0) ? (bx % 8) * (G / 8) + bx / 8 : bx;
    const int lo = args.ph_lo, hi = args.ph_hi, sub = args.sub;
    for (int u = tid0; u < (LDS_BYTES - 131072) / 4; u += NTHREADS) ((LAS unsigned*)(lds + 131072))[u] = 0u;
    __syncthreads();
    XcdBarrier bar; bar.bar = (unsigned*)(args.ws + WS_CTL) + CW_BAR; bar.x = 0; bar.st = nullptr;
    if (hi - lo > 1) bar = xcd_barrier_post((unsigned*)(args.ws + WS_CTL) + CW_BAR, (volatile LAS unsigned*)(lds + 131072 + 320) + 8);
    constexpr bool EN_MIX = (EN_ATTN || EN_RNN);

    if (lo == 0) {
        Ptrs P0;
#pragma unroll
        for (int i = 0; i < 22; ++i) P0.in[i] = args.in[i];
        P0.out = args.out; P0.ws = args.ws;
        if (PH_ON(10)) p0_prologue(P0, lds, vcu, G, __builtin_amdgcn_readfirstlane(tid0 >> 6), tid0 & 63);
        if (hi > 1) xcd_barrier(bar);
    }
    for (int ph = (lo == 0 ? 1 : lo); ph < hi; ++ph) {
        int tid_ = threadIdx.x; asm volatile("" : "+v"(tid_));
        const int tid = tid_, lane = tid & 63, wave = __builtin_amdgcn_readfirstlane(tid >> 6);
        const __attribute__((address_space(4))) unsigned char* kap = (const __attribute__((address_space(4))) unsigned char*)__builtin_amdgcn_kernarg_segment_ptr();
        asm volatile("" : "+s"(kap));
        const __attribute__((address_space(4))) Args* ap = (const __attribute__((address_space(4))) Args*)kap;
        Ptrs P;
#pragma unroll
        for (int i = 0; i < 22; ++i) P.in[i] = ap->in[i];
        P.out = ap->out; P.ws = ap->ws;
        unsigned char* ws = P.ws;
        bf16raw* XB = (bf16raw*)(ws + WS_XB); float* X1 = (float*)(ws + WS_X1); float* XRES = (float*)(ws + WS_XRES);
        bf16raw* Qb = (bf16raw*)(ws + WS_Q); bf16raw* Kb = (bf16raw*)(ws + WS_K); bf16raw* Vb = (bf16raw*)(ws + WS_V); bf16raw* XRb = (bf16raw*)(ws + WS_XR);
        bf16raw* YG = (bf16raw*)(ws + WS_YG); bf16raw* GA = (bf16raw*)(ws + WS_GA); bf16raw* GR = (bf16raw*)(ws + WS_GR);
        bf16raw* AO = (bf16raw*)(ws + WS_AO); bf16raw* HG = (bf16raw*)(ws + WS_HG); bf16raw* YA = (bf16raw*)(ws + WS_YA); bf16raw* MG = (bf16raw*)(ws + WS_MG);
        bf16raw* XS = (bf16raw*)(ws + WS_XS); bf16raw* HID = (bf16raw*)(ws + WS_HID); bf16raw* YB = (bf16raw*)(ws + WS_YB);
        {
            const int l = (ph - 1) / 10, s = (ph - 1) % 10;
            const float* xin = l == 0 ? P.in[0] : XRES;
            if (s == 0 && PH_ON(0)) {
                if (EN_MIX) {
                    pg8::Gemm g{XB, (const bf16raw*)(ws + WS_WIN) + (size_t)l * NIN * DM, TOK, NIN, DM}; pg8::StaticOrder S; S.init(TOK, NIN, G, bx);
                    pg8::EpiInProj E{Qb, Kb, Vb, XRb, YG, GA, GR, (const float*)(ws + WS_RCOS), (const float*)(ws + WS_RSIN)};
                    pg8::gemm_phase<pg8::EpiInProj, pg8::StaticOrder, true, true>(lds, g, S, E);
                }
            } else if (s == 1 && PH_ON(1)) {
                if (EN_ATTN && (sub & 1)) {
                    attn::Seam<attn::bf16> SM;
                    const attn::BlockRef<attn::bf16, attn::bf16> b0 = attn_block(P, l, 2 * vcu), b1 = attn_block(P, l, 2 * vcu + 1);
                    attn::causal_swa_prime<attn::bf16, attn::bf16>(b0, WIN, (char*)lds_raw, SM);
                    attn::causal_swa_block<attn::bf16, attn::bf16>(b0, b1, SEQ, WIN, (char*)lds_raw, SM);
                    attn::causal_swa_block<attn::bf16, attn::bf16>(b1, b1, SEQ, WIN, (char*)lds_raw, SM);
                    __syncthreads();
                }
                if (EN_RNN && (sub & 2)) {
                    scan_phase<false>(P, lds, l, vcu, G, tid, wave, lane);
                }
            } else if (s == 2 && PH_ON(2)) {
                if (EN_RNN && (sub & 2)) carry_prep(P, lds, vcu, G, tid);
                if (EN_ATTN && (sub & 1)) {
                    pg8::Gemm g{AO, (const bf16raw*)(ws + WS_WAO) + (size_t)l * DM * DM, TOK, DM, DM}; pg8::StaticOrder S; S.init(TOK, DM, G, bx);
                    pg8::EpiGate E{GA, nullptr, YA};
                    pg8::gemm_phase<pg8::EpiGate, pg8::StaticOrder, true, true>(lds, g, S, E);
                    __syncthreads();
                }
                if (EN_RNN && (sub & 2)) {
                    scan_phase<true>(P, lds, l, vcu, G, tid, wave, lane);
                }
            } else if (s == 3 && PH_ON(3)) {
                if (EN_RNN) {
                    pg8::Gemm g{HG, (const bf16raw*)(ws + WS_WRO) + (size_t)l * DM * DM, TOK, DM, DM}; pg8::StaticOrder S; S.init(TOK, DM, G, bx);
                    pg8::EpiGate E{GR, EN_ATTN ? YA : nullptr, MG};
                    pg8::gemm_phase<pg8::EpiGate, pg8::StaticOrder, true, true>(lds, g, S, E);
                }
            } else if (s == 4 && PH_ON(4)) {
                if (EN_MIX) {
                    pg8::Gemm g{EN_RNN ? MG : YA, (const bf16raw*)(ws + WS_WOUT) + (size_t)l * DM * DM, TOK, DM, DM}; pg8::StaticOrder S; S.init(TOK, DM, G, bx);
                    pg8::EpiResid E{xin, X1, ALPHA};
                    pg8::gemm_phase<pg8::EpiResid, pg8::StaticOrder, true, true>(lds, g, S, E);
                } else resid_only_phase(P, xin, vcu, G, wave, lane);
            } else if (s == 5 && PH_ON(5)) {
                ln1_router_phase(P, lds, l, vcu, G, tid, wave, lane);
            } else if (s == 6 && PH_ON(6)) {
                if (EN_MOE) gather_phase(P, lds, l, vcu, G, tid, wave, lane);
            } else if (s == 7 && PH_ON(7)) {
                if (EN_MOE) {
                    const int* tile_e = (const int*)(ws + WS_ROUTE + RT_TILEE); const int nt = __builtin_amdgcn_readfirstlane(tile_e[MOE_TILES_MAX]);
                    pg8::Gemm g{XS, (const bf16raw*)(ws + WS_WGU) + (size_t)l * NEXP * 1024 * DM, nt * 256, 1024, DM}; pg8::MoeOrder S{tile_e, nt * 4, G, vcu};
                    pg8::EpiSwiGLU E{HID};
                    pg8::gemm_phase<pg8::EpiSwiGLU, pg8::MoeOrder, true, true>(lds, g, S, E);
                }
            } else if (s == 8 && PH_ON(8)) {
                if (EN_MOE) {
                    const int* tile_e = (const int*)(ws + WS_ROUTE + RT_TILEE); const int nt = __builtin_amdgcn_readfirstlane(tile_e[MOE_TILES_MAX]);
                    pg8::Gemm g{HID, (const bf16raw*)(ws + WS_WD) + (size_t)l * NEXP * DM * DEXP, nt * 256, 1024, DEXP}; pg8::MoeOrder S{tile_e, nt * 4, G, vcu};
                    pg8::EpiDown E{(const int*)(ws + WS_ROUTE + RT_SLOT), (const float*)(ws + WS_ROUTE + RT_ROWW), YB};
                    pg8::gemm_phase<pg8::EpiDown, pg8::MoeOrder, true, true>(lds, g, S, E);
                }
            } else if (PH_ON(9)) {
                ln2_phase(P, l, l == DEPTH - 1 ? P.out : XRES, EN_MOE != 0, vcu, G, wave, lane);
            }
        }
        if (ph + 1 < hi) { xcd_barrier(bar);
#if defined(BAR_TWICE)
            xcd_barrier(bar);
#endif
        }
    }
}

extern "C" void kernel_launch(void* const* d_in, const int* in_sizes, int n_in, void* d_out, int out_size, void* d_ws, size_t ws_size, hipStream_t stream) {
    static int grid = 0;
    if (grid == 0) {
        if (n_in != 22 || in_sizes[0] != TOK * DM || out_size != TOK * DM || ws_size < WS_END) { fprintf(stderr, "kernel_launch: unexpected shapes (n_in %d, in0 %d, out %d, ws %zu)\n", n_in, n_in > 0 ? in_sizes[0] : -1, out_size, ws_size); grid = -1; return; }
        int dev = 0, cus = 0, per_cu = 0;
        if (hipGetDevice(&dev) != hipSuccess || hipDeviceGetAttribute(&cus, hipDeviceAttributeMultiprocessorCount, dev) != hipSuccess) { grid = -1; return; }
        if (hipFuncSetAttribute((const void*)fwd_kernel, hipFuncAttributeMaxDynamicSharedMemorySize, LDS_BYTES) != hipSuccess) { fprintf(stderr, "kernel_launch: hipFuncSetAttribute failed\n"); grid = -1; return; }
        if (hipOccupancyMaxActiveBlocksPerMultiprocessor(&per_cu, (const void*)fwd_kernel, NTHREADS, LDS_BYTES) != hipSuccess || per_cu < 1) fprintf(stderr, "kernel_launch: occupancy query reports %d\n", per_cu);
        (void)hipGetLastError();
        grid = cus;
        if (grid != 256) { fprintf(stderr, "kernel_launch: built for 256 CUs, device has %d\n", cus); grid = -1; return; }
    }
    if (grid < 0) return;
    if (hipMemsetAsync((char*)d_ws + WS_CTL, 0, CTL_ZERO_BYTES, stream) != hipSuccess) { fprintf(stderr, "kernel_launch: hipMemsetAsync failed\n"); return; }
    Args a{};
    for (int i = 0; i < 22; ++i) a.in[i] = (const float*)d_in[i];
    a.out = (float*)d_out; a.ws = (unsigned char*)d_ws;
#if MK_ONE_LAUNCH
    a.ph_lo = 0; a.ph_hi = N_PHASES; a.sub = 3;
    void* params[] = {&a};
    const hipError_t le = hipLaunchCooperativeKernel((const void*)fwd_kernel, dim3(grid), dim3(NTHREADS), params, LDS_BYTES, stream);
    if (le != hipSuccess) fprintf(stderr, "kernel_launch: cooperative launch failed: %s\n", hipGetErrorName(le));
#else
    for (int ph = 0; ph < N_PHASES; ++ph) {
        a.ph_lo = ph; a.ph_hi = ph + 1;
        const int s = ph == 0 ? 10 : (ph - 1) % 10;
        if (REP_MASK != 0 && (s == 1 || s == 2)) {
            for (int part = 1; part <= 2; ++part) { a.sub = part; const int bit = s == 1 ? 10 + part : 12 + part;
                for (int rep = 0; rep < REPS(bit) * REPS(s); ++rep) hipLaunchKernelGGL(fwd_kernel, dim3(grid), dim3(NTHREADS), LDS_BYTES, stream, a); }
        } else { a.sub = 3; for (int rep = 0; rep < REPS(s); ++rep) hipLaunchKernelGGL(fwd_kernel, dim3(grid), dim3(NTHREADS), LDS_BYTES, stream, a); }
    }
#endif
}
```

```cpp
#include <hip/hip_runtime.h>
#include <hip/hip_bf16.h>
#include <cstdio>
#include <cstdint>

#ifndef MK_ONE_LAUNCH
#define MK_ONE_LAUNCH 1
#endif
#ifndef EN_ATTN
#define EN_ATTN 1
#endif
#ifndef EN_RNN
#define EN_RNN 1
#endif
#ifndef EN_MOE
#define EN_MOE 1
#endif

constexpr int DM = 1024, NBATCH = 2, SEQ = 8192, TOK = NBATCH * SEQ, DEPTH = 4;
constexpr int HD = 128, NQH = 8, NKVH = 2, KVW = NKVH * HD, WIN = 128;
constexpr int NIN = 5632;
constexpr int NEXP = 32, DEXP = 512, MOE_ROWS_MAX = 40960, MOE_TILES_MAX = 160;
constexpr float ALPHA = 1.6817928305074292f;
constexpr float LN_EPS = 1e-5f;
constexpr int CHUNK = 128, NCHUNK = SEQ / CHUNK;

__device__ __forceinline__ float bperm_f(int srclane, float v) { return __builtin_bit_cast(float, __builtin_amdgcn_ds_bpermute(srclane << 2, __builtin_bit_cast(int, v))); }

namespace pg8 {
#define PG8_LAS __attribute__((address_space(3)))
typedef unsigned short bf16_t;
typedef short bf16x8 __attribute__((ext_vector_type(8)));
typedef float f32x4 __attribute__((ext_vector_type(4)));
typedef unsigned u32x4 __attribute__((ext_vector_type(4)));
constexpr int BM = 256, BK = 64, HALF = 128, HTB = HALF * BK * 2  , STAGE_BYTES = 8 * HTB, NXCD = 8, WGM = 8;

__host__ __device__ __forceinline__ int lds_byte(int r, int c) { const int st = (r >> 4) * 2 + (c >> 5), rr = r & 15, cc = c & 31, ob = rr * 64 + cc * 2; return st * 1024 + (ob ^ (((ob >> 9) & 1) << 5)); }
__host__ __device__ __forceinline__ void stage_rc(int b, int& R, int& C) { const int st = b / 1024, sb = b % 1024, swz = sb ^ (((sb >> 9) & 1) << 5); R = (st >> 1) * 16 + swz / 64; C = (st & 1) * 32 + (swz % 64) / 2; }
__host__ __device__ __forceinline__ int perm32(int rho) { const int n = rho >> 4, i = rho & 15; return 8 * (i >> 2) + 4 * n + (i & 3); }

struct Unit { int pm, pn, pa; };
struct Gemm { const bf16_t* A; const bf16_t* Bt; int M, N, K; };

struct StaticOrder {
    int nM, nN, nwg, G, c;
    __host__ __device__ void init(int M, int N, int G_, int c_) { nM = M / BM; nN = N / BM; nwg = nM * nN; G = G_; c = c_; }
    __host__ __device__ bool next(int i, Unit& u) const {
        const long L = (long)i * G + c; if (L >= nwg) return false;
        int wgid = (int)L; { const int q = nwg / NXCD, r = nwg % NXCD, xcd = wgid % NXCD, off = wgid / NXCD; wgid = (xcd < r ? xcd * (q + 1) : r * (q + 1) + (xcd - r) * q) + off; }
        const int nig = WGM * nN, gid = wgid / nig, fm = gid * WGM, gsz = (nM - fm) < WGM ? (nM - fm) : WGM;
        u.pm = fm + ((wgid % nig) % gsz); u.pn = (wgid % nig) / gsz; return true;
    }
    __device__ __forceinline__ void a_ready(const Unit&) const {}
    __device__ __forceinline__ void done(const Unit&) const {}
};

__device__ __forceinline__ unsigned cvt_pk_bf16(float lo, float hi) { unsigned r; asm volatile("v_cvt_pk_bf16_f32 %0, %1, %2" : "=v"(r) : "v"(lo), "v"(hi)); return r; }
typedef float f32x2 __attribute__((ext_vector_type(2)));
__device__ __forceinline__ f32x2 gelu_pk(f32x2 v) {
    const f32x2 av = __builtin_elementwise_abs(v), d = av * 0.2316418882f + 1.0f;
    f32x2 t; t.x = __builtin_amdgcn_rcpf(d.x); t.y = __builtin_amdgcn_rcpf(d.y);
    f32x2 q = t * 0.5307027145f + (-0.7265760135f); q = q * t + 0.7107068705f; q = q * t + (-0.142248368f); q = q * t + 0.127414796f; q = q * t;
    const f32x2 s = (v * v) * (-0.72134752044f);
    f32x2 e; e.x = __builtin_amdgcn_exp2f(s.x); e.y = __builtin_amdgcn_exp2f(s.y);
    const f32x2 m = v * (q * e), r = v - m;
    f32x2 o; o.x = v.x < 0.f ? m.x : r.x; o.y = v.y < 0.f ? m.y : r.y; return o;
}

typedef unsigned u32x2 __attribute__((ext_vector_type(2)));
__device__ __forceinline__ float bf_lo(unsigned w) { return __builtin_bit_cast(float, w << 16); }
__device__ __forceinline__ float bf_hi(unsigned w) { return __builtin_bit_cast(float, w & 0xffff0000u); }
__device__ __forceinline__ float sigmoid_f(float x) { return __builtin_amdgcn_rcpf(1.0f + __builtin_amdgcn_exp2f(-1.4426950408889634f * x)); }
__device__ __forceinline__ float gelu_tanh_f(float x) { const float z2 = 1.5957691216057308f * (x + 0.044715f * x * x * x); return x * sigmoid_f(z2); }
__device__ __forceinline__ u32x4 pack8f(f32x4 a, f32x4 b) { u32x4 w; w.x = cvt_pk_bf16(a[0], a[1]); w.y = cvt_pk_bf16(a[2], a[3]); w.z = cvt_pk_bf16(b[0], b[1]); w.w = cvt_pk_bf16(b[2], b[3]); return w; }

struct EpiInProj {
    static constexpr bool PERM = true, AFTER_DRAIN = false;
    bf16_t *Q, *K, *V, *XR, *YG, *GA, *GR; const float* rcos; const float* rsin;
    __device__ __forceinline__ void operator()(const f32x4 (&acc)[2][2][4][2], const Unit& u, int wr, int wc, int fr, int fq) const {
        const int pn = u.pn, row0 = u.pm * BM + wr * 64 + fr, cl = wc * 32 + 8 * fq;
        if (pn < 5) {
            bf16_t* base = pn < 4 ? Q + pn * 256 : K; const int ld = pn < 4 ? 1024 : 256; const int d0 = 16 * wc + 4 * fq;
#pragma unroll
            for (int ai = 0; ai < 2; ++ai)
#pragma unroll
                for (int m = 0; m < 4; ++m) { const int row = row0 + ai * HALF + m * 16, t = row & 8191;
                    const f32x4 cs = *(const f32x4*)(rcos + t * 64 + d0), sn = *(const f32x4*)(rsin + t * 64 + d0);
#pragma unroll
                    for (int bj = 0; bj < 2; ++bj) { const f32x4 x1 = acc[ai][bj][m][0], x2 = acc[ai][bj][m][1];
                        const f32x4 o1 = x1 * cs - x2 * sn, o2 = x2 * cs + x1 * sn;
                        *(u32x4*)(base + (size_t)row * ld + bj * HALF + cl) = pack8f(o1, o2); } }
        } else {
            bf16_t* base; int ld = 1024, act = 0;
            if (pn == 5) { base = V; ld = 256; }
            else if (pn < 10) { base = XR + (pn - 6) * 256; }
            else if (pn < 14) { base = YG + (pn - 10) * 256; act = 1; }
            else if (pn < 18) { base = GA + (pn - 14) * 256; act = 2; }
            else { base = GR + (pn - 18) * 256; act = 2; }
#pragma unroll
            for (int ai = 0; ai < 2; ++ai)
#pragma unroll
                for (int m = 0; m < 4; ++m) { const int row = row0 + ai * HALF + m * 16;
#pragma unroll
                    for (int bj = 0; bj < 2; ++bj) { f32x4 v0 = acc[ai][bj][m][0], v1 = acc[ai][bj][m][1];
                        if (act == 1) {
#pragma unroll
                            for (int e = 0; e < 4; ++e) { v0[e] = gelu_tanh_f(v0[e]); v1[e] = gelu_tanh_f(v1[e]); } }
                        else if (act == 2) {
#pragma unroll
                            for (int e = 0; e < 4; ++e) { v0[e] = sigmoid_f(v0[e]); v1[e] = sigmoid_f(v1[e]); } }
                        *(u32x4*)(base + (size_t)row * ld + bj * HALF + cl) = pack8f(v0, v1); } }
        }
    }
};
struct EpiGate {
    static constexpr bool PERM = true, AFTER_DRAIN = false;
    const bf16_t* gate; const bf16_t* add; bf16_t* out;
    __device__ __forceinline__ void operator()(const f32x4 (&acc)[2][2][4][2], const Unit& u, int wr, int wc, int fr, int fq) const {
        const int row0 = u.pm * BM + wr * 64 + fr, col0 = u.pn * BM + wc * 32 + 8 * fq;
#pragma unroll
        for (int ai = 0; ai < 2; ++ai)
#pragma unroll
            for (int m = 0; m < 4; ++m) { const size_t ro = (size_t)(row0 + ai * HALF + m * 16) * 1024 + col0;
#pragma unroll
                for (int bj = 0; bj < 2; ++bj) { const u32x4 g = *(const u32x4*)(gate + ro + bj * HALF);
                    f32x4 v0 = acc[ai][bj][m][0], v1 = acc[ai][bj][m][1];
                    v0[0] *= bf_lo(g.x); v0[1] *= bf_hi(g.x); v0[2] *= bf_lo(g.y); v0[3] *= bf_hi(g.y);
                    v1[0] *= bf_lo(g.z); v1[1] *= bf_hi(g.z); v1[2] *= bf_lo(g.w); v1[3] *= bf_hi(g.w);
                    if (add) { const u32x4 a = *(const u32x4*)(add + ro + bj * HALF);
                        v0[0] += bf_lo(a.x); v0[1] += bf_hi(a.x); v0[2] += bf_lo(a.y); v0[3] += bf_hi(a.y);
                        v1[0] += bf_lo(a.z); v1[1] += bf_hi(a.z); v1[2] += bf_lo(a.w); v1[3] += bf_hi(a.w); }
                    *(u32x4*)(out + ro + bj * HALF) = pack8f(v0, v1); } }
    }
};
struct EpiResid {
    static constexpr bool PERM = false, AFTER_DRAIN = false;
    const float* xin; float* out; float alpha;
    __device__ __forceinline__ void operator()(const f32x4 (&acc)[2][2][4][2], const Unit& u, int wr, int wc, int fr, int fq) const {
        const int row0 = u.pm * BM + wr * 64 + fr, col0 = u.pn * BM + wc * 32 + 4 * fq;
#pragma unroll
        for (int ai = 0; ai < 2; ++ai)
#pragma unroll
            for (int m = 0; m < 4; ++m) { const size_t ro = (size_t)(row0 + ai * HALF + m * 16) * 1024 + col0;
#pragma unroll
                for (int bj = 0; bj < 2; ++bj)
#pragma unroll
                    for (int n = 0; n < 2; ++n) { const f32x4 xv = *(const f32x4*)(xin + ro + bj * HALF + n * 16);
                        *(f32x4*)(out + ro + bj * HALF + n * 16) = xv * alpha + acc[ai][bj][m][n]; } }
    }
};
struct EpiSwiGLU {
    static constexpr bool PERM = true, AFTER_DRAIN = false;
    bf16_t* hid;
    __device__ __forceinline__ void operator()(const f32x4 (&acc)[2][2][4][2], const Unit& u, int wr, int wc, int fr, int fq) const {
        const int row0 = u.pm * BM + wr * 64 + fr, col0 = (u.pn & 3) * 128 + wc * 32 + 8 * fq;
#pragma unroll
        for (int ai = 0; ai < 2; ++ai)
#pragma unroll
            for (int m = 0; m < 4; ++m) { f32x4 h0, h1;
#pragma unroll
                for (int e = 0; e < 4; ++e) { const float g0 = acc[ai][0][m][0][e], g1 = acc[ai][0][m][1][e];
                    h0[e] = g0 * sigmoid_f(g0) * acc[ai][1][m][0][e]; h1[e] = g1 * sigmoid_f(g1) * acc[ai][1][m][1][e]; }
                *(u32x4*)(hid + (size_t)(row0 + ai * HALF + m * 16) * 512 + col0) = pack8f(h0, h1); }
    }
};
constexpr int MOE_CAP = 16384;
struct MoeTables { const PG8_LAS int* tile_e; const PG8_LAS int* tfirst; const PG8_LAS int* cnt; const int* slot2; const float* roww2; };
struct EpiDown {
    static constexpr bool PERM = true, AFTER_DRAIN = false;
    MoeTables T; bf16_t* yb;
    __device__ __forceinline__ void operator()(const f32x4 (&acc)[2][2][4][2], const Unit& u, int wr, int wc, int fr, int fq) const {
        const int e = u.pn >> 2, p0 = u.pa * BM + wr * 64 + fr, col0 = (u.pn & 3) * 256 + wc * 32 + 8 * fq, ce = T.cnt[e];
#pragma unroll
        for (int ai = 0; ai < 2; ++ai)
#pragma unroll
            for (int m = 0; m < 4; ++m) { const int p = p0 + ai * HALF + m * 16;
                if (p < ce) { const int s = T.slot2[e * MOE_CAP + p]; const float w = T.roww2[e * MOE_CAP + p];
#pragma unroll
                    for (int bj = 0; bj < 2; ++bj) *(u32x4*)(yb + (size_t)s * 1024 + col0 + bj * HALF) = pack8f(acc[ai][bj][m][0] * w, acc[ai][bj][m][1] * w); }
                asm volatile("" ::: "memory"); }
    }
};
struct MoeOrder {
    MoeTables T; int nunits, G, c, rowbytes;
    __device__ __forceinline__ bool next(int i, Unit& u) const {
        const int L = i * G + c; if (L >= nunits) return false;
        const int t = L >> 2, e = __builtin_amdgcn_readfirstlane(T.tile_e[t]);
        u.pm = t; u.pn = e * 4 + (L & 3); u.pa = t - __builtin_amdgcn_readfirstlane(T.tfirst[e]); return true;
    }
    __device__ __forceinline__ unsigned row_off(const Unit& u, int rloc) const {
        const int e = u.pn >> 2, p = u.pa * BM + rloc;
        const int s = p < T.cnt[e] ? T.slot2[e * MOE_CAP + p] : 0;
        return (unsigned)(s >> 1) * (unsigned)rowbytes;
    }
    __device__ __forceinline__ void a_ready(const Unit&) const {}
    __device__ __forceinline__ void done(const Unit&) const {}
};
struct PanelStats {
    unsigned* xbuf;
    unsigned* cnt;
    unsigned* tmo;
    int ntn; float eps;
    unsigned code;
    __device__ __forceinline__ bool run(const f32x4 (&v)[2][2][4][2], const Unit& u, int wr, int wc, int fr, int fq, PG8_LAS unsigned char* lds, int wid, int lane) const {
        typedef float f32x2v __attribute__((ext_vector_type(2)));
        PG8_LAS f32x2v* P = (PG8_LAS f32x2v*)lds;
        PG8_LAS f32x2v* S = (PG8_LAS f32x2v*)(lds + 8192);
        PG8_LAS unsigned* flag = (PG8_LAS unsigned*)(lds + 8192 + 2048);
#pragma unroll
        for (int ai = 0; ai < 2; ++ai)
#pragma unroll
            for (int m = 0; m < 4; ++m) {
                float s = 0.f;
#pragma unroll
                for (int bj = 0; bj < 2; ++bj)
#pragma unroll
                    for (int n = 0; n < 2; ++n) { const f32x4 x = v[ai][bj][m][n]; s += (x[0] + x[1]) + (x[2] + x[3]); }
                s += bperm_f(lane ^ 16, s); s += bperm_f(lane ^ 32, s);
                const float mw = s * (1.0f / 64.0f); float q = 0.f;
#pragma unroll
                for (int bj = 0; bj < 2; ++bj)
#pragma unroll
                    for (int n = 0; n < 2; ++n) { const f32x4 d = v[ai][bj][m][n] - mw; q += (d[0] * d[0] + d[1] * d[1]) + (d[2] * d[2] + d[3] * d[3]); }
                q += bperm_f(lane ^ 16, q); q += bperm_f(lane ^ 32, q);
                if (fq == 0) P[(ai * HALF + wr * 64 + m * 16 + fr) * 4 + wc] = (f32x2v){mw, q};
            }
        asm volatile("s_waitcnt lgkmcnt(0)" ::: "memory"); __builtin_amdgcn_s_barrier(); asm volatile("" ::: "memory");
        const int row = wid * 32 + (lane & 31);
        if (lane < 32) {
            const f32x2v a = P[row * 4 + 0], b = P[row * 4 + 1], c = P[row * 4 + 2], d = P[row * 4 + 3];
            const float mt = (a.x + b.x + c.x + d.x) * 0.25f;
            const float da = a.x - mt, db = b.x - mt, dc = c.x - mt, dd = d.x - mt;
            const float m2 = (a.y + b.y) + (c.y + d.y) + 64.0f * ((da * da + db * db) + (dc * dc + dd * dd));
            unsigned long long* slot = (unsigned long long*)xbuf + ((size_t)(u.pm * BM + row) * 4 + u.pn);
            __hip_atomic_store(slot, ((unsigned long long)__float_as_uint(m2) << 32) | __float_as_uint(mt), __ATOMIC_RELAXED, __HIP_MEMORY_SCOPE_AGENT);
        }
        asm volatile("s_waitcnt vmcnt(0)" ::: "memory");
        if (lane == 0) __hip_atomic_fetch_add(cnt + 64 * u.pm, 1u, __ATOMIC_RELAXED, __HIP_MEMORY_SCOPE_AGENT);
        if (wid == 0) {
            bool dead = false; const unsigned long long t0 = __builtin_amdgcn_s_memrealtime(); const unsigned want = 8u * (unsigned)ntn;
            for (;;) {
                if ((unsigned)__builtin_amdgcn_readfirstlane(__hip_atomic_load(cnt + 64 * u.pm, __ATOMIC_RELAXED, __HIP_MEMORY_SCOPE_AGENT)) >= want) break;
                if (__builtin_amdgcn_s_memrealtime() - t0 > 2000000ull) {
                    if (lane == 0) { unsigned expect = 0u; __hip_atomic_compare_exchange_strong(tmo + 1, &expect, code | (unsigned)(u.pm & 0xff), __ATOMIC_RELAXED, __ATOMIC_RELAXED, __HIP_MEMORY_SCOPE_AGENT);
                                     __hip_atomic_store(tmo, 1u, __ATOMIC_RELAXED, __HIP_MEMORY_SCOPE_AGENT); }
                    dead = true; break; }
                __builtin_amdgcn_s_sleep(2);
            }
            __builtin_amdgcn_fence(__ATOMIC_ACQUIRE, "agent");
            if (lane == 0) flag[0] = dead ? 1u : 0u;
        }
        asm volatile("s_waitcnt vmcnt(0) lgkmcnt(0)" ::: "memory"); __builtin_amdgcn_s_barrier(); asm volatile("" ::: "memory");
        const bool bad = flag[0] != 0u;
        if (lane < 32) {
            const unsigned long long* slot = (const unsigned long long*)xbuf + (size_t)(u.pm * BM + row) * 4; float mt[4], m2[4]; float ms = 0.f;
#pragma unroll
            for (int t = 0; t < 4; ++t) { if (t < ntn) { const unsigned long long w = __hip_atomic_load(slot + t, __ATOMIC_RELAXED, __HIP_MEMORY_SCOPE_AGENT); mt[t] = __uint_as_float((unsigned)w); m2[t] = __uint_as_float((unsigned)(w >> 32)); } else { mt[t] = 0.f; m2[t] = 0.f; } ms += mt[t]; }
            const float mean = ms / (float)ntn; float q = 0.f;
#pragma unroll
            for (int t = 0; t < 4; ++t) if (t < ntn) { const float dm = mt[t] - mean; q += m2[t] + 256.0f * dm * dm; }
            S[row] = (f32x2v){mean, 1.0f / sqrtf(q / (256.0f * (float)ntn) + eps)};
        }
        asm volatile("s_waitcnt lgkmcnt(0)" ::: "memory"); __builtin_amdgcn_s_barrier(); asm volatile("" ::: "memory");
        return bad;
    }
};
struct EpiLn1 {
    static constexpr bool PERM = false, AFTER_DRAIN = true;
    const float* xin; float* x1o; bf16_t* xb; const float* gam; const float* bet; PanelStats st; unsigned poison;
    static constexpr float alpha = 1.6817928305074292f;
    __device__ __forceinline__ void fused(f32x4 (&acc)[2][2][4][2], const Unit& u, int wr, int wc, int fr, int fq, PG8_LAS unsigned char* lds, int wid, int lane) const {
        typedef float f32x2v __attribute__((ext_vector_type(2)));
        const PG8_LAS f32x2v* S = (const PG8_LAS f32x2v*)(lds + 8192);
        const int col0 = u.pn * BM + wc * 32 + 4 * fq;
        const unsigned bo0 = (unsigned)((u.pm * BM + wr * 64 + fr) * 1024 + col0) * 4u;
        const char* xinb = (const char*)xin; char* x1b = (char*)x1o; char* xbb = (char*)xb;
#pragma unroll
        for (int ai = 0; ai < 2; ++ai)
#pragma unroll
            for (int m = 0; m < 4; ++m) { const unsigned bo = bo0 + (unsigned)((ai * HALF + m * 16) * 4096);
#pragma unroll
                for (int bj = 0; bj < 2; ++bj)
#pragma unroll
                    for (int n = 0; n < 2; ++n) acc[ai][bj][m][n] += *(const f32x4*)(xinb + bo + (bj * HALF + n * 16) * 4) * alpha;
                asm volatile("" : "+v"(acc[ai][0][m][0]), "+v"(acc[ai][0][m][1]), "+v"(acc[ai][1][m][0]), "+v"(acc[ai][1][m][1]));
                if (m & 1) asm volatile("" ::: "memory"); }
        const bool bad = st.run(acc, u, wr, wc, fr, fq, lds, wid, lane) || poison != 0u;
        const float qnan = __builtin_nanf("");
#pragma unroll
        for (int bj = 0; bj < 2; ++bj)
#pragma unroll
            for (int n = 0; n < 2; ++n) {
                const f32x4 gv = *(const f32x4*)(gam + col0 + bj * HALF + n * 16), bv = *(const f32x4*)(bet + col0 + bj * HALF + n * 16);
#pragma unroll
                for (int ai = 0; ai < 2; ++ai)
#pragma unroll
                    for (int m = 0; m < 4; ++m) { const int r = ai * HALF + wr * 64 + m * 16 + fr; const f32x2v sr = S[r];
                        const unsigned bo = bo0 + (unsigned)((ai * HALF + m * 16) * 4096 + (bj * HALF + n * 16) * 4);
                        f32x4 o = (acc[ai][bj][m][n] - sr.x) * sr.y * gv + bv;
                        if (bad) o = (f32x4){qnan, qnan, qnan, qnan};
                        *(f32x4*)(x1b + bo) = o;
                        u32x2 w; w.x = cvt_pk_bf16(o[0], o[1]); w.y = cvt_pk_bf16(o[2], o[3]); *(u32x2*)(xbb + (bo >> 1)) = w; }
                asm volatile("" ::: "memory"); }
    }
};
template <class Epi, class Sched, bool ALIGN_EPI = false, bool SP2 = false, bool GATHER = false>
__device__ __forceinline__ void gemm_phase(PG8_LAS unsigned char* lds, const Gemm g, const Sched& S, const Epi& E) {
    int tid_ = threadIdx.x; asm volatile("" : "+v"(tid_));
    const int tid = tid_, wid = __builtin_amdgcn_readfirstlane(tid >> 6), lane = tid & 63, wr = wid >> 2, wc = wid & 3, fr = lane & 15, fq = lane >> 4;
    const int K = g.K, nt = K / BK;
    unsigned voffA[2], voffB[2];
#pragma unroll
    for (int i = 0; i < 2; ++i) { int R, C; stage_rc(tid * 16 + i * 8192, R, C); const int Rb = Epi::PERM ? ((R & ~31) + perm32(R & 31)) : R;
        voffA[i] = (unsigned)(R * K + C) * 2u; voffB[i] = (unsigned)(Rb * K + C) * 2u; }
    const size_t kstep = (size_t)(BK * 2);
    const size_t hstep = (size_t)HALF * K * 2;
    const size_t tstep = 2 * hstep;
    const unsigned ldsw = (unsigned)wid * 1024u;
    const int aoff = lds_byte(wr * 64 + fr, fq * 8), boff = lds_byte(wc * 32 + fr, fq * 8);
#define PG8_SA(b, h) (((b) * 2 + (h)) * HTB)
#define PG8_SB(b, h) ((4 + (b) * 2 + (h)) * HTB)
#define PG8_STAGE(bufoff, gbase, voff) do { _Pragma("unroll") for (int _i = 0; _i < 2; ++_i) \
        __builtin_amdgcn_global_load_lds((const unsigned*)((const char*)(gbase) + (voff)[_i]), (PG8_LAS unsigned*)(lds + (bufoff) + ldsw + _i * 8192), 16, 0, 0); } while (0)
#define PG8_LDA(dst, b, h) do { _Pragma("unroll") for (int m = 0; m < 4; ++m) _Pragma("unroll") for (int k = 0; k < 2; ++k) dst[m][k] = *(const PG8_LAS bf16x8*)(lds + PG8_SA(b, h) + aoff + m * 2048 + k * 1024); } while (0)
#define PG8_LDB(dst, b, h) do { _Pragma("unroll") for (int n = 0; n < 2; ++n) _Pragma("unroll") for (int k = 0; k < 2; ++k) dst[n][k] = *(const PG8_LAS bf16x8*)(lds + PG8_SB(b, h) + boff + n * 2048 + k * 1024); } while (0)
#define PG8_MMA(ai, bj, At, Bt) do { __builtin_amdgcn_s_setprio(1); _Pragma("unroll") for (int m = 0; m < 4; ++m) _Pragma("unroll") for (int n = 0; n < 2; ++n) _Pragma("unroll") for (int k = 0; k < 2; ++k) \
        acc[ai][bj][m][n] = __builtin_amdgcn_mfma_f32_16x16x32_bf16(Bt[n][k], At[m][k], acc[ai][bj][m][n], 0, 0, 0); __builtin_amdgcn_s_setprio(0); } while (0)
#define PG8_WAIT_V(n) asm volatile("s_waitcnt vmcnt(" #n ")" ::: "memory")
#define PG8_WAIT_L(n) asm volatile("s_waitcnt lgkmcnt(" #n ")" ::: "memory")
#define PG8_BAR __builtin_amdgcn_s_barrier()
#define PG8_SCHED __builtin_amdgcn_sched_barrier(0)
    Unit cur, nxt; int ui = 0;
    if (!S.next(0, cur)) return;
    f32x4 acc[2][2][4][2];
#pragma unroll
    for (int a = 0; a < 2; ++a)
#pragma unroll
        for (int b = 0; b < 2; ++b)
#pragma unroll
            for (int m = 0; m < 4; ++m)
#pragma unroll
                for (int n = 0; n < 2; ++n) acc[a][b][m][n] = (f32x4){0.f, 0.f, 0.f, 0.f};
    bf16x8 At[4][2], B0[2][2], B1[2][2];
    static_assert(!GATHER || SP2, "GATHER is implemented on the SP2 loop only");
    const char* cA = GATHER ? (const char*)g.A : (const char*)g.A + (size_t)cur.pm * tstep; const char* cB = (const char*)g.Bt + (size_t)cur.pn * tstep;
    unsigned gcu[2][2] = {{0u, 0u}, {0u, 0u}}, gnx[2][2] = {{0u, 0u}, {0u, 0u}};
    if constexpr (GATHER) {
        int R0, C0; stage_rc(tid * 16, R0, C0);
#pragma unroll
        for (int h = 0; h < 2; ++h)
#pragma unroll
            for (int i = 0; i < 2; ++i) { gcu[h][i] = S.row_off(cur, h * HALF + R0 + 64 * i) + (unsigned)C0 * 2u; gnx[h][i] = gcu[h][i]; }
    }
#define PG8_STAGE_A(bufoff, ptr, H, UNEXT) do { if constexpr (GATHER) { const unsigned sel_[2] = {(UNEXT) ? gnx[H][0] : gcu[H][0], (UNEXT) ? gnx[H][1] : gcu[H][1]}; PG8_STAGE(bufoff, ptr, sel_); } \
        else { PG8_STAGE(bufoff, (ptr) + (H) * hstep, voffA); } } while (0)
    S.a_ready(cur);
    if constexpr (SP2) {
        PG8_STAGE(PG8_SB(0, 0), cB, voffB); PG8_STAGE(PG8_SB(0, 1), cB + hstep, voffB); PG8_STAGE_A(PG8_SA(0, 0), cA, 0, false); PG8_STAGE_A(PG8_SA(0, 1), cA, 1, false);
        if (wr == 1) PG8_BAR;
        PG8_WAIT_V(2); PG8_BAR;
        PG8_STAGE(PG8_SB(1, 0), cB + kstep, voffB); PG8_STAGE_A(PG8_SA(1, 0), cA + kstep, 0, false); PG8_STAGE(PG8_SB(1, 1), cB + hstep + kstep, voffB);
        PG8_WAIT_V(6); PG8_BAR;
    } else {
        PG8_STAGE(PG8_SB(0, 0), cB, voffB); PG8_STAGE(PG8_SA(0, 0), cA, voffA); PG8_STAGE(PG8_SB(0, 1), cB + hstep, voffB); PG8_STAGE(PG8_SA(0, 1), cA + hstep, voffA);
        if (wr == 1) PG8_BAR;
        PG8_WAIT_V(4); PG8_BAR;
        PG8_STAGE(PG8_SB(1, 0), cB + kstep, voffB); PG8_STAGE(PG8_SA(1, 0), cA + kstep, voffA); PG8_STAGE(PG8_SB(1, 1), cB + hstep + kstep, voffB);
        PG8_WAIT_V(6); PG8_BAR;
    }
    for (;;) {
        const bool has_next = S.next(ui + 1, nxt);
        if constexpr (GATHER) { if (has_next) { int R0, C0; stage_rc(tid * 16, R0, C0);
#pragma unroll
            for (int h = 0; h < 2; ++h)
#pragma unroll
                for (int i = 0; i < 2; ++i) gnx[h][i] = S.row_off(nxt, h * HALF + R0 + 64 * i) + (unsigned)C0 * 2u; } }
        const char* nA = GATHER ? cA : (has_next ? (const char*)g.A + (size_t)nxt.pm * tstep : cA); const char* nB = has_next ? (const char*)g.Bt + (size_t)nxt.pn * tstep : cB;
        for (int t = 0; t < nt; t += 2) {
            const bool last = (t == nt - 2);
            const char* a1 = cA + (size_t)(t + 1) * kstep;
            const char* a2 = last ? nA : cA + (size_t)(t + 2) * kstep; const char* b2 = last ? nB : cB + (size_t)(t + 2) * kstep;
            const char* a3 = a2 + kstep; const char* b3 = b2 + kstep;
            if (last && has_next) S.a_ready(nxt);
            if constexpr (SP2) {
            PG8_LDB(B0, 0, 0); PG8_LDB(B1, 0, 1); PG8_SCHED; PG8_LDA(At, 0, 0); PG8_STAGE_A(PG8_SA(1, 1), a1, 1, false);
            PG8_WAIT_V(8); PG8_WAIT_L(0); PG8_BAR; PG8_MMA(0, 0, At, B0); PG8_MMA(0, 1, At, B1); PG8_BAR; PG8_SCHED;
            PG8_LDA(At, 0, 1); PG8_STAGE(PG8_SB(0, 0), b2, voffB); PG8_STAGE(PG8_SB(0, 1), b2 + hstep, voffB); PG8_STAGE_A(PG8_SA(0, 0), a2, 0, last);
            PG8_WAIT_V(8); PG8_WAIT_L(0); PG8_BAR; PG8_MMA(1, 0, At, B0); PG8_MMA(1, 1, At, B1); PG8_BAR; PG8_SCHED;
            PG8_LDB(B0, 1, 0); PG8_LDB(B1, 1, 1); PG8_SCHED; PG8_LDA(At, 1, 0); PG8_STAGE_A(PG8_SA(0, 1), a2, 1, last);
            PG8_WAIT_V(8); PG8_WAIT_L(0); PG8_BAR; PG8_MMA(0, 0, At, B0); PG8_MMA(0, 1, At, B1); PG8_BAR; PG8_SCHED;
            PG8_LDA(At, 1, 1); PG8_STAGE(PG8_SB(1, 0), b3, voffB); PG8_STAGE(PG8_SB(1, 1), b3 + hstep, voffB); PG8_STAGE_A(PG8_SA(1, 0), a3, 0, last);
            PG8_WAIT_V(8); PG8_WAIT_L(0); PG8_BAR; PG8_MMA(1, 0, At, B0); PG8_MMA(1, 1, At, B1); PG8_BAR; PG8_SCHED;
            } else {
            PG8_LDB(B0, 0, 0); PG8_SCHED; PG8_LDA(At, 0, 0); PG8_STAGE(PG8_SA(1, 1), a1 + hstep, voffA);
            PG8_WAIT_L(8); PG8_BAR; PG8_WAIT_L(0); PG8_MMA(0, 0, At, B0); PG8_BAR; PG8_SCHED;
            PG8_LDB(B1, 0, 1); PG8_STAGE(PG8_SB(0, 0), b2, voffB);
            PG8_BAR; PG8_WAIT_L(0); PG8_MMA(0, 1, At, B1); PG8_BAR;
            PG8_LDA(At, 0, 1); PG8_STAGE(PG8_SA(0, 0), a2, voffA);
            PG8_BAR; PG8_WAIT_L(0); PG8_MMA(1, 0, At, B0); PG8_BAR; PG8_SCHED;
            PG8_STAGE(PG8_SB(0, 1), b2 + hstep, voffB);
            PG8_WAIT_V(6); PG8_BAR; PG8_MMA(1, 1, At, B1); PG8_BAR;
            PG8_LDB(B0, 1, 0); PG8_SCHED; PG8_LDA(At, 1, 0); PG8_STAGE(PG8_SA(0, 1), a2 + hstep, voffA);
            PG8_WAIT_L(8); PG8_BAR; PG8_WAIT_L(0); PG8_MMA(0, 0, At, B0); PG8_BAR; PG8_SCHED;
            PG8_LDB(B1, 1, 1); PG8_STAGE(PG8_SB(1, 0), b3, voffB);
            PG8_BAR; PG8_WAIT_L(0); PG8_MMA(0, 1, At, B1); PG8_BAR;
            PG8_LDA(At, 1, 1); PG8_STAGE(PG8_SA(1, 0), a3, voffA);
            PG8_BAR; PG8_WAIT_L(0); PG8_MMA(1, 0, At, B0); PG8_BAR; PG8_SCHED;
            PG8_STAGE(PG8_SB(1, 1), b3 + hstep, voffB);
            PG8_WAIT_V(6); PG8_BAR; PG8_MMA(1, 1, At, B1); PG8_BAR;
            }
        }
        if constexpr (ALIGN_EPI) { if (wr == 0) PG8_BAR; }
        if constexpr (!Epi::AFTER_DRAIN) { E(acc, cur, wr, wc, fr, fq); S.done(cur); }
        if (!has_next) break;
#pragma unroll
        for (int a = 0; a < 2; ++a)
#pragma unroll
            for (int b = 0; b < 2; ++b)
#pragma unroll
                for (int m = 0; m < 4; ++m)
#pragma unroll
                    for (int n = 0; n < 2; ++n) acc[a][b][m][n] = (f32x4){0.f, 0.f, 0.f, 0.f};
        cur = nxt; cA = nA; cB = nB; ++ui;
        if constexpr (GATHER) {
#pragma unroll
            for (int h = 0; h < 2; ++h)
#pragma unroll
                for (int i = 0; i < 2; ++i) gcu[h][i] = gnx[h][i]; }
        if constexpr (ALIGN_EPI) { if (wr == 1) PG8_BAR; }
    }
    PG8_WAIT_V(0);
    if constexpr (!ALIGN_EPI) { if (wr == 0) PG8_BAR; }
    PG8_BAR;
    if constexpr (Epi::AFTER_DRAIN) { E.fused(acc, cur, wr, wc, fr, fq, lds, wid, lane); S.done(cur); }
#undef PG8_SA
#undef PG8_SB
#undef PG8_STAGE
#undef PG8_STAGE_A
#undef PG8_LDA
#undef PG8_LDB
#undef PG8_MMA
#undef PG8_WAIT_V
#undef PG8_WAIT_L
#undef PG8_BAR
#undef PG8_SCHED
}
}
namespace attn {
constexpr int D = 128, QS = 1024, KVS = 256, OS = 1024;
constexpr float THR = 8.f;
constexpr bool WSKIP = true;
constexpr float SCALE = 0.08838834764831845f;
constexpr int NW = 8, QBLK = 32, KVBLK = 64, QB = NW * QBLK;
constexpr int SHM_V = KVBLK * D * 2, SHM_K = KVBLK * D * 2;
constexpr int LDS_BYTES = 2 * SHM_V + 2 * SHM_K + NW * 64 * 4;
using bf16 = __hip_bfloat16;
typedef short bf16x8 __attribute__((ext_vector_type(8)));
typedef short s16x4 __attribute__((ext_vector_type(4)));
typedef float f32x16 __attribute__((ext_vector_type(16)));
typedef float f32x4 __attribute__((ext_vector_type(4)));
typedef unsigned u32x4 __attribute__((ext_vector_type(4)));
template <class A, class Bt> struct same_t { static constexpr bool v = false; };
template <class A> struct same_t<A, A> { static constexpr bool v = true; };

#define KSWZ(row, colB) ((row) * 256 + ((colB) ^ (((row) & 7) << 4)))
#define SBAR() __builtin_amdgcn_sched_barrier(0)
__device__ __forceinline__ int v_st(int k, int c) { const int kk = (k & ~0xC) | ((k & 4) << 1) | ((k & 8) >> 1); return ((kk >> 3) * 4 + (c >> 5)) * 512 + ((kk & 7) * 32 + (c & 31)) * 2; }
__device__ __forceinline__ int v_rd_base(int lane) { return ((lane & 3) << 3) | (((lane >> 2) & 3) << 6) | (((lane >> 4) & 1) << 5) | (((lane >> 5) & 1) << 8); }
constexpr int v_rd_off(int d0, int ks, int half) { return d0 * 512 + ks * 4096 + half * 2048; }
__device__ __forceinline__ int crow(int r, int hi) { return (r & 3) + 8 * (r >> 2) + 4 * hi; }
__device__ __forceinline__ unsigned cvtpk(float lo, float hi) {
    unsigned r; asm volatile("v_cvt_pk_bf16_f32 %0, %1, %2" : "=v"(r) : "v"(lo), "v"(hi)); return r;
}
__device__ __forceinline__ bf16x8 pack8(f32x4 a, f32x4 b) {
    u32x4 w = {cvtpk(a[0], a[1]), cvtpk(a[2], a[3]), cvtpk(b[0], b[1]), cvtpk(b[2], b[3])};
    return *reinterpret_cast<bf16x8*>(&w);
}
template <class T> __device__ __forceinline__ bf16x8 load8(const T* p) {
    if constexpr (same_t<T, float>::v) { return pack8(*(const f32x4*)p, *(const f32x4*)(p + 4)); }
    else { return *reinterpret_cast<const bf16x8*>(p); }
}
__device__ __forceinline__ void mask_tile(f32x16& p0, f32x16& p1, int dq, unsigned W) {
    const float NEG = -__builtin_inff();
#pragma unroll
    for (int r = 0; r < 16; ++r) {
        const int c = (r & 3) + 8 * (r >> 2);
        if ((unsigned)(dq - c) >= W) p0[r] = NEG;
        if ((unsigned)(dq - c - 32) >= W) p1[r] = NEG;
    }
}
__device__ __forceinline__ void partialSM(f32x16& p0, f32x16& p1, float& m_reg, float& mn, float& alpha) {
    float pmax = p0[0]; for (int r = 1; r < 16; ++r) pmax = fmaxf(pmax, p0[r]); for (int r = 0; r < 16; ++r) pmax = fmaxf(pmax, p1[r]);
    { auto rr = __builtin_amdgcn_permlane32_swap(__float_as_uint(pmax), __float_as_uint(pmax), false, false);
      pmax = fmaxf(__uint_as_float(rr[0]), __uint_as_float(rr[1])); }
    constexpr float C2 = 1.4426950408889634f * SCALE;
    if (__builtin_expect(__all((pmax - m_reg) * SCALE <= THR), 1)) { mn = m_reg; alpha = 1.f; }
    else { mn = fmaxf(m_reg, pmax); alpha = __builtin_amdgcn_exp2f((m_reg - mn) * C2); m_reg = mn; }
    const float mnL = -mn * C2;
    for (int r = 0; r < 16; ++r) p0[r] = fmaf(p0[r], C2, mnL); for (int r = 0; r < 16; ++r) p1[r] = fmaf(p1[r], C2, mnL);
    for (int r = 0; r < 16; ++r) p0[r] = __builtin_amdgcn_exp2f(p0[r]);
}
__device__ __forceinline__ void finishSM(f32x16& p0, f32x16& p1, float alpha, float& l_reg, bf16x8& pa0, bf16x8& pa1, bf16x8& pa2, bf16x8& pa3) {
    for (int r = 0; r < 16; ++r) p1[r] = __builtin_amdgcn_exp2f(p1[r]);
    float ps = 0; for (int r = 0; r < 16; ++r) ps += p0[r]; for (int r = 0; r < 16; ++r) ps += p1[r];
    { auto rr = __builtin_amdgcn_permlane32_swap(__float_as_uint(ps), __float_as_uint(ps), false, false);
      ps = __uint_as_float(rr[0]) + __uint_as_float(rr[1]); }
    l_reg = l_reg * alpha + ps;
#define PK4(P, B_, OUT) do { unsigned a0 = cvtpk(P[B_+0], P[B_+1]), a1 = cvtpk(P[B_+2], P[B_+3]);                          \
        unsigned b0 = cvtpk(P[B_+4], P[B_+5]), b1 = cvtpk(P[B_+6], P[B_+7]);                                             \
        auto r0 = __builtin_amdgcn_permlane32_swap(a0, b0, false, false); auto r1 = __builtin_amdgcn_permlane32_swap(a1, b1, false, false); \
        u32x4 w = {r0[0], r1[0], r0[1], r1[1]}; OUT = *reinterpret_cast<bf16x8*>(&w); } while (0)
    PK4(p0, 0, pa0); PK4(p0, 8, pa1); PK4(p1, 0, pa2); PK4(p1, 8, pa3);
#undef PK4
}
template <int KB, bool SK>
__device__ __forceinline__ void qkt(f32x16& p0, f32x16& p1, const char* K_lds, int r32, int hi, const bf16x8* qr, bool act) {
    if (SK && !act) { const float NEG = -__builtin_inff();
#pragma unroll
        for (int r = 0; r < 16; ++r) { p0[r] = NEG; p1[r] = NEG; } return; }
    p0 = f32x16{}; p1 = f32x16{};
    const char* kb[4];
#pragma unroll
    for (int dd = 0; dd < 4; ++dd) kb[dd] = K_lds + KB * SHM_K + KSWZ(r32, (dd * 16 + hi * 8) * 2);
#pragma unroll
    for (int d0 = 0; d0 < 8; ++d0) { const char* a = kb[d0 & 3] + (d0 >> 2) * 128;
        bf16x8 b0 = *reinterpret_cast<const bf16x8*>(a);
        bf16x8 b1 = *reinterpret_cast<const bf16x8*>(a + 32 * 256);
        p0 = __builtin_amdgcn_mfma_f32_32x32x16_bf16(b0, qr[d0], p0, 0, 0, 0);
        p1 = __builtin_amdgcn_mfma_f32_32x32x16_bf16(b1, qr[d0], p1, 0, 0, 0); }
}
template <int VB, bool SK>
__device__ __forceinline__ void pv_tile(f32x16* o, int vb0, bf16x8 pa0, bf16x8 pa1, bf16x8 pa2, bf16x8 pa3, bool act) {
    if (SK && !act) return;
#define TRRD(dst, off) asm volatile("ds_read_b64_tr_b16 %0, %1 offset:%2" : "=&v"(dst) : "v"(vb0), "i"(off) : "memory")
#define PV_D0(d0) do { s16x4 l0, l1, l2, l3, h0, h1, h2, h3; constexpr int b_ = VB * SHM_V + v_rd_off(d0, 0, 0);     \
        TRRD(l0, b_); TRRD(h0, b_ + 2048); TRRD(l1, b_ + 4096); TRRD(h1, b_ + 6144); TRRD(l2, b_ + 8192); TRRD(h2, b_ + 10240); TRRD(l3, b_ + 12288); TRRD(h3, b_ + 14336); \
        asm volatile("s_waitcnt lgkmcnt(0)" ::: "memory"); SBAR();                 \
        o[d0] = __builtin_amdgcn_mfma_f32_32x32x16_bf16(pa0, (bf16x8){l0[0], l0[1], l0[2], l0[3], h0[0], h0[1], h0[2], h0[3]}, o[d0], 0, 0, 0);   \
        o[d0] = __builtin_amdgcn_mfma_f32_32x32x16_bf16(pa1, (bf16x8){l1[0], l1[1], l1[2], l1[3], h1[0], h1[1], h1[2], h1[3]}, o[d0], 0, 0, 0);   \
        o[d0] = __builtin_amdgcn_mfma_f32_32x32x16_bf16(pa2, (bf16x8){l2[0], l2[1], l2[2], l2[3], h2[0], h2[1], h2[2], h2[3]}, o[d0], 0, 0, 0);   \
        o[d0] = __builtin_amdgcn_mfma_f32_32x32x16_bf16(pa3, (bf16x8){l3[0], l3[1], l3[2], l3[3], h3[0], h3[1], h3[2], h3[3]}, o[d0], 0, 0, 0); } while (0)
    PV_D0(0); PV_D0(1); PV_D0(2); PV_D0(3);
#undef PV_D0
#undef TRRD
}

template <class TIn, class TOut> struct BlockRef { const TIn* Q; const TIn* K; const TIn* V; TOut* O; int P0; float sinkl2; };
template <class TIn> struct Seam {
    bf16x8 qr[8];
    bf16x8 st_v0, st_v1, st_k0, st_k1; f32x4 sf0, sf1, sf2, sf3;
    f32x4 tq[16];
};
__device__ __forceinline__ int swa_jlo(int P0, int W) { const int lowk = P0 - W; return lowk > 0 ? lowk / KVBLK : 0; }
#define ROW(p, k0, rr) ((p) + (size_t)((k0) + (rr)) * KVS + sc)
#define VMW() asm volatile("s_waitcnt vmcnt(0)" ::: "memory")
#define VMWN(n) asm volatile("s_waitcnt vmcnt(%0)" :: "i"(n) : "memory")
#define SLOAD_H(Kp, Vp, k0) do { S.st_v0 = load8<TIn>(ROW(Vp, k0, sr)); S.st_v1 = load8<TIn>(ROW(Vp, k0, 32 + sr));              \
                         S.st_k0 = load8<TIn>(ROW(Kp, k0, sr)); S.st_k1 = load8<TIn>(ROW(Kp, k0, 32 + sr)); } while (0)
#define SWRITE_HK(bf) do { *(bf16x8*)(K_lds + (bf) * SHM_K + kws) = S.st_k0; *(bf16x8*)(K_lds + (bf) * SHM_K + kws + 32 * 256) = S.st_k1; } while (0)
#define SWRITE_HV(bf) do { *(bf16x8*)(V_lds + (bf) * SHM_V + vst0) = S.st_v0; *(bf16x8*)(V_lds + (bf) * SHM_V + vst1) = S.st_v1; } while (0)
#define SWRITE_H(bf) do { SWRITE_HV(bf); SWRITE_HK(bf); } while (0)
#define SLOAD_F(p, k0) do { S.sf0 = *(const f32x4*)ROW(p, k0, sr); S.sf1 = *(const f32x4*)(ROW(p, k0, sr) + 4);                \
                            S.sf2 = *(const f32x4*)ROW(p, k0, 32 + sr); S.sf3 = *(const f32x4*)(ROW(p, k0, 32 + sr) + 4); } while (0)
#define SWRITE_KF(bf) do { *(bf16x8*)(K_lds + (bf) * SHM_K + kws) = pack8(S.sf0, S.sf1); *(bf16x8*)(K_lds + (bf) * SHM_K + kws + 32 * 256) = pack8(S.sf2, S.sf3); } while (0)
#define SWRITE_VF(bf) do { *(bf16x8*)(V_lds + (bf) * SHM_V + vst0) = pack8(S.sf0, S.sf1); *(bf16x8*)(V_lds + (bf) * SHM_V + vst1) = pack8(S.sf2, S.sf3); } while (0)
template <class TIn, class TOut>
__device__ __forceinline__ void causal_swa_prime(const BlockRef<TIn, TOut>& cur, int W, char* lds, Seam<TIn>& S) {
    constexpr bool F32 = same_t<TIn, float>::v;
    int tid_ = threadIdx.x; asm volatile("" : "+v"(tid_));
    const int tid = tid_, wid = __builtin_amdgcn_readfirstlane(tid >> 6), lane = tid & 63, r32 = lane & 31, hi = lane >> 5;
    const int sr = tid >> 4, sc = (tid & 15) * 8, kws = KSWZ(sr, sc * 2); char* K_lds = lds + 2 * SHM_V;
    const int kb0 = swa_jlo(cur.P0, W) * KVBLK;
    for (int d0 = 0; d0 < 8; ++d0) S.qr[d0] = load8<TIn>(cur.Q + (size_t)(wid * QBLK + r32) * QS + d0 * 16 + hi * 8);
    if constexpr (F32) { SLOAD_F((const float*)cur.K, kb0); VMW(); SWRITE_KF(0); SBAR(); SLOAD_F((const float*)cur.V, kb0); }
    else { SLOAD_H(cur.K, cur.V, kb0); VMW(); SWRITE_HK(0); }
    __syncthreads();
}
template <class TIn, class TOut>
__device__ __forceinline__ void causal_swa_block(const BlockRef<TIn, TOut>& cur, const BlockRef<TIn, TOut>& nxt, int skv, int W, char* lds, Seam<TIn>& S) {
    constexpr bool F32 = same_t<TIn, float>::v;
    int tid_ = threadIdx.x; asm volatile("" : "+v"(tid_));
    const int tid = tid_, wid = __builtin_amdgcn_readfirstlane(tid >> 6), lane = tid & 63, r32 = lane & 31, hi = lane >> 5;
    const int j_lo = swa_jlo(cur.P0, W);
    int j_hi = (cur.P0 + QB - 1 + W) / KVBLK + 1; if (j_hi > skv / KVBLK) j_hi = skv / KVBLK;
    const int NT = j_hi - j_lo;
    const int kbn = swa_jlo(nxt.P0, W) * KVBLK;
    const int qlo = cur.P0 + wid * QBLK, qm = qlo + r32 - 4 * hi;
    char* V_lds = lds; char* K_lds = lds + 2 * SHM_V;
    float* ws = (float*)(lds + 2 * SHM_V + 2 * SHM_K) + wid * 64; float* li_l = ws, * al_l = ws + 32;
    float m_reg = -1e30f, l_reg = 0; f32x16 o[4] = {};
    const int sr = tid >> 4, sc = (tid & 15) * 8, vst0 = v_st(sr, sc), vst1 = v_st(32 + sr, sc), kws = KSWZ(sr, sc * 2);
    const int vb0 = (int)(uintptr_t)V_lds + v_rd_base(lane);
    const TIn* Kh = cur.K; const TIn* Vh = cur.V;
#define RESC(a) do { if (__any((a) < 1.f)) { if (hi == 0) al_l[r32] = (a); asm volatile("s_waitcnt lgkmcnt(0)" ::: "memory");              \
                     for (int d_ = 0; d_ < 4; ++d_) for (int r = 0; r < 16; ++r) o[d_][r] *= al_l[crow(r, hi)]; } } while (0)
#define KBASE(t) ((j_lo + (t)) * KVBLK)
#define ACT(t) (KBASE(t) <= qlo + QBLK - 1 + W && KBASE(t) + KVBLK - 1 >= qlo - W)
#define MASKT(P0_, P1_, t) do { const int kb_ = KBASE(t); if ((!SK || ACT(t)) && (kb_ + KVBLK - 1 > qlo + W || kb_ < qlo + QBLK - 1 - W)) mask_tile(P0_, P1_, qm - kb_ + W, (unsigned)(2 * W + 1)); } while (0)
    constexpr int NQL = F32 ? 16 : 8;
    constexpr bool SK = WSKIP && !F32;
#define SEAM_K0() do { VMWN(NQL); if constexpr (F32) { SWRITE_KF(0); SBAR(); SLOAD_F((const float*)nxt.V, kbn); } else { SWRITE_HK(0); } SBAR(); } while (0)
    f32x16 pA0, pA1, pB0, pB1; float mnA, mnB, alA, alB; bf16x8 pa0, pa1, pa2, pa3;
    if constexpr (F32) { VMW(); SWRITE_VF(0); SBAR(); } else { SWRITE_HV(0); SBAR(); }
    if (NT > 1) { if constexpr (F32) SLOAD_F((const float*)Kh, KBASE(1)); else SLOAD_H(Kh, Vh, KBASE(1)); }
    SBAR(); qkt<0, SK>(pA0, pA1, K_lds, r32, hi, S.qr, ACT(0));
    if constexpr (F32) { if (NT > 1) { VMW(); SWRITE_KF(1); SBAR(); SLOAD_F((const float*)Vh, KBASE(1)); } }
    MASKT(pA0, pA1, 0); partialSM(pA0, pA1, m_reg, mnA, alA);
    if (NT > 1) { VMW(); if constexpr (F32) { SWRITE_VF(1); SBAR(); if (NT > 2) SLOAD_F((const float*)Kh, KBASE(2)); } else SWRITE_H(1); }
    __syncthreads();
#define HALF_STEP(PX0, PX1, mnX, alX, PY0, PY1, alY, t, KB, VB, SB) do {                                                      \
        SBAR(); qkt<KB, SK>(PX0, PX1, K_lds, r32, hi, S.qr, ACT(t));                                             \
        finishSM(PY0, PY1, alY, l_reg, pa0, pa1, pa2, pa3); SBAR();                                                           \
        if ((t) + 1 < NT) { if constexpr (F32) { VMW(); SWRITE_KF(SB); SBAR(); SLOAD_F((const float*)Vh, KBASE((t) + 1)); }  \
                            else { SLOAD_H(Kh, Vh, KBASE((t) + 1)); } SBAR(); }                                               \
        pv_tile<VB, SK>(o, vb0, pa0, pa1, pa2, pa3, ACT((t) - 1)); MASKT(PX0, PX1, (t)); partialSM(PX0, PX1, m_reg, mnX, alX);                                        \
        __syncthreads();                                                                                                      \
        if ((t) + 1 < NT) { VMW(); if constexpr (F32) { SWRITE_VF(SB); SBAR(); if ((t) + 2 < NT) SLOAD_F((const float*)Kh, KBASE((t) + 2)); } \
                            else { SWRITE_H(SB); } }                                                                          \
        RESC(alX); __syncthreads(); } while (0)
    for (int t = 1; t + 1 < NT; t += 2) {
        HALF_STEP(pB0, pB1, mnB, alB, pA0, pA1, alA, t, 1, 0, 0);
        HALF_STEP(pA0, pA1, mnA, alA, pB0, pB1, alB, t + 1, 0, 1, 1);
    }
    const bool even = (NT & 1) == 0;
    if (even) { SBAR(); qkt<1, SK>(pB0, pB1, K_lds, r32, hi, S.qr, ACT(NT - 1)); SBAR(); }
#define QROW(e) (nxt.Q + (size_t)(wid * QBLK + r32) * QS + ((e) >> 1) * 16 + hi * 8 + ((e) & 1) * 4)
    if constexpr (F32) { SLOAD_F((const float*)nxt.K, kbn); SBAR();
#pragma unroll
        for (int e = 0; e < 8; ++e) S.tq[e] = *(const f32x4*)QROW(e); }
    else { SLOAD_H(nxt.K, nxt.V, kbn); SBAR();
#pragma unroll
        for (int d0 = 0; d0 < 8; ++d0) S.qr[d0] = load8<TIn>(nxt.Q + (size_t)(wid * QBLK + r32) * QS + d0 * 16 + hi * 8); }
    SBAR();
    finishSM(pA0, pA1, alA, l_reg, pa0, pa1, pa2, pa3); SBAR();
    if constexpr (F32) {
#pragma unroll
        for (int e = 8; e < 16; ++e) S.tq[e] = *(const f32x4*)QROW(e); SBAR(); }
#undef QROW
    pv_tile<0, SK>(o, vb0, pa0, pa1, pa2, pa3, ACT(even ? NT - 2 : NT - 1));
    if (even) { MASKT(pB0, pB1, NT - 1); partialSM(pB0, pB1, m_reg, mnB, alB); __syncthreads(); RESC(alB);
        finishSM(pB0, pB1, alB, l_reg, pa0, pa1, pa2, pa3); SBAR(); pv_tile<1, SK>(o, vb0, pa0, pa1, pa2, pa3, ACT(NT - 1)); }
    SBAR(); SEAM_K0();
    l_reg += __builtin_amdgcn_exp2f(cur.sinkl2 - m_reg * (1.4426950408889634f * SCALE));
    if (hi == 0) li_l[r32] = l_reg; asm volatile("s_waitcnt lgkmcnt(0)" ::: "memory");
    float rli[16];
#pragma unroll
    for (int r = 0; r < 16; ++r) rli[r] = __builtin_amdgcn_rcpf(li_l[crow(r, hi)]);
    TOut* Ow = cur.O + (size_t)(wid * QBLK) * OS;
#pragma unroll
    for (int r = 0; r < 16; ++r) { const int orow = crow(r, hi);
#pragma unroll
        for (int d0 = 0; d0 < 4; ++d0) { const float v = o[d0][r] * rli[r];
            if constexpr (same_t<TOut, float>::v) { Ow[(size_t)orow * OS + d0 * 32 + r32] = v; }
            else { const float vn = bperm_f(lane ^ 1, v);
                   if ((r32 & 1) == 0) *(unsigned*)(Ow + (size_t)orow * OS + d0 * 32 + r32) = cvtpk(v, vn); } } }
    if constexpr (F32) {
#pragma unroll
        for (int d0 = 0; d0 < 8; ++d0) S.qr[d0] = pack8(S.tq[2 * d0], S.tq[2 * d0 + 1]); }
    __syncthreads();
#undef RESC
#undef KBASE
#undef ACT
#undef MASKT
#undef SEAM_K0
#undef HALF_STEP
}
#undef ROW
#undef VMW
#undef VMWN
#undef SLOAD_H
#undef SWRITE_HK
#undef SWRITE_HV
#undef SWRITE_H
#undef SLOAD_F
#undef SWRITE_KF
#undef SWRITE_VF


}
#undef KSWZ
#undef SBAR

constexpr int NWAVES = 8, NTHREADS = NWAVES * 64;
constexpr size_t MiB = 1u << 20;
constexpr size_t WS_CTL = 0, CTL_ZERO_BYTES = 1 * MiB;
constexpr size_t WS_WIN = 2 * MiB;
constexpr size_t WS_WAO = 46 * MiB, WS_WRO = 54 * MiB, WS_WOUT = 62 * MiB;
constexpr size_t WS_WG = 70 * MiB;
constexpr size_t WS_WR = 74 * MiB;
constexpr size_t WS_RCOS = 75 * MiB, WS_RSIN = 77 * MiB;
constexpr size_t WS_SP = 79 * MiB;
constexpr size_t WS_ROUTE = 80 * MiB;
constexpr size_t WS_SUMM = 82 * MiB;
constexpr size_t WS_SLOT2 = 87 * MiB, WS_ROWW2 = 89 * MiB;
constexpr size_t WS_XBUF = 86 * MiB;
constexpr size_t WS_WGU = 96 * MiB;
constexpr size_t WS_WD = 352 * MiB;
constexpr size_t WS_XB = 480 * MiB;
constexpr size_t WS_X1 = 512 * MiB;
constexpr size_t WS_XRES = 576 * MiB;
constexpr size_t WS_Q = 640 * MiB, WS_K = 672 * MiB, WS_V = 680 * MiB, WS_XR = 688 * MiB, WS_YG = 720 * MiB, WS_GA = 752 * MiB, WS_GR = 784 * MiB;
constexpr size_t WS_AO = 816 * MiB, WS_HG = 848 * MiB, WS_YA = 880 * MiB, WS_MG = 912 * MiB, WS_SS = 944 * MiB, WS_END = 976 * MiB;
constexpr size_t WS_XS = 640 * MiB;
constexpr size_t WS_HID = 720 * MiB;
constexpr size_t WS_YB = 760 * MiB;
constexpr size_t RT_TOKE = 0, RT_TOKPOS = 131072, RT_TOKW = 262144, RT_SLOT = 393216, RT_ROWW = 557056, RT_TILEE = 720896, RT_BLKCNT = 786432;
constexpr int CW_BAR = 4096;
constexpr int CW_CNT = 16384;
constexpr int CW_SEAM = 32768;

constexpr int LDS_BYTES = 147456;

#define GAS __attribute__((address_space(1)))
#define LAS __attribute__((address_space(3)))
typedef unsigned short bf16raw;
typedef unsigned v4u __attribute__((ext_vector_type(4)));
typedef unsigned v2u __attribute__((ext_vector_type(2)));
typedef float f32x4 __attribute__((ext_vector_type(4)));
typedef float f32x2 __attribute__((ext_vector_type(2)));
typedef short bf16x8 __attribute__((ext_vector_type(8)));
#define LDS_WAIT() asm volatile("s_waitcnt lgkmcnt(0)" ::: "memory")
__device__ __forceinline__ unsigned f2bf(float f) { unsigned u = __builtin_bit_cast(unsigned, f); return (u + 0x7fffu + ((u >> 16) & 1u)) >> 16; }
__device__ __forceinline__ unsigned pk2(float lo, float hi) { return f2bf(lo) | (f2bf(hi) << 16); }
__device__ __forceinline__ float bflo(unsigned w) { return __builtin_bit_cast(float, w << 16); }
__device__ __forceinline__ float bfhi(unsigned w) { return __builtin_bit_cast(float, w & 0xffff0000u); }
template <int CTRL, int ROWMASK> __device__ __forceinline__ float dpp_f(float v) { return __builtin_bit_cast(float, __builtin_amdgcn_update_dpp(0, __builtin_bit_cast(int, v), CTRL, ROWMASK, 0xF, false)); }
__device__ __forceinline__ float wave_sum(float v) {
    v += dpp_f<0xB1, 0xF>(v);
    v += dpp_f<0x4E, 0xF>(v);
    v += dpp_f<0x141, 0xF>(v);
    v += dpp_f<0x140, 0xF>(v);
    v += dpp_f<0x142, 0xA>(v);
    v += dpp_f<0x143, 0xC>(v);
    return __builtin_bit_cast(float, __builtin_amdgcn_readlane(__builtin_bit_cast(int, v), 63));
}

#define XB_TMO      128
#define XB_XCNT(j)  (256  + 64 * (j))
#define XB_XSUB(j)  (1280 + 64 * (j))
#define XB_XGEN(j)  (2304 + 64 * (j))
#define XB_TOP      3328
#define XB_TOPGEN   3392
#define XCD_BAR_WORDS 3456
#define XB_SPIN_CAP (1u << 18)

__device__ __forceinline__ unsigned xb_ld(unsigned* p)              { return __hip_atomic_load(p, __ATOMIC_RELAXED, __HIP_MEMORY_SCOPE_AGENT); }
__device__ __forceinline__ unsigned xb_add(unsigned* p, unsigned v) { return __hip_atomic_fetch_add(p, v, __ATOMIC_RELAXED, __HIP_MEMORY_SCOPE_AGENT); }
__device__ __forceinline__ unsigned xb_xcc_id() { return (unsigned)__builtin_amdgcn_s_getreg((3 << 11) | 20) & 0xFu; }
#define XB_SPIN(cond, bar) do { unsigned _sp = 0; while (cond) { __builtin_amdgcn_s_sleep(1); \
    if ((++_sp & 255u) == 0u) { if (xb_ld(&(bar)[XB_TMO])) break; if (_sp > XB_SPIN_CAP) { atomicAdd(&(bar)[XB_TMO], 1u); break; } } } } while (0)

struct XcdBarrier {
    unsigned* bar; unsigned x;
    volatile LAS unsigned* st;
};

__device__ __forceinline__ XcdBarrier xcd_barrier_post(unsigned* bar, volatile LAS unsigned* st) {
    XcdBarrier b; b.bar = bar; b.x = xb_xcc_id(); b.st = st;
    if (threadIdx.x == 0) (void)xb_add(&bar[XB_XCNT(b.x)], 1u);
    return b;
}
__device__ __forceinline__ void xcd_barrier_complete(unsigned* bar, unsigned x, unsigned& nloc, unsigned& nx) {
    const unsigned G = gridDim.x * gridDim.y * gridDim.z;
    unsigned sum, cnt, mine, sp = 0u;
    for (;;) {
        sum = 0u; cnt = 0u; mine = 0u;
#pragma unroll
        for (unsigned j = 0; j < 16; ++j) { const unsigned c = xb_ld(&bar[XB_XCNT(j)]); sum += c; cnt += (c > 0u) ? 1u : 0u; mine = (j == x) ? c : mine; }
        if (sum == G) break;
        __builtin_amdgcn_s_sleep(1);
        if ((++sp & 255u) == 0u) { if (xb_ld(&bar[XB_TMO])) break; if (sp > XB_SPIN_CAP) { atomicAdd(&bar[XB_TMO], 1u); break; } }
    }
    nloc = mine > 0u ? mine : 1u; nx = cnt > 0u ? cnt : 1u;
}

__device__ __forceinline__ void xcd_barrier(const XcdBarrier& b) {
    asm volatile("s_waitcnt vmcnt(0)" ::: "memory");
    __syncthreads();
    if (threadIdx.x == 0) {
        unsigned* bar = b.bar;
        __builtin_amdgcn_s_waitcnt(0);
        unsigned nloc = b.st[0], nx = b.st[1];
        if (nloc == 0u) { xcd_barrier_complete(bar, b.x, nloc, nx); b.st[0] = nloc; b.st[1] = nx; }
        const unsigned old = xb_add(&bar[XB_XSUB(b.x)], 1u);
        const unsigned gen = old / nloc;
        if (old + 1u == (gen + 1u) * nloc) {
            __builtin_amdgcn_fence(__ATOMIC_RELEASE, "agent");
            asm volatile("s_waitcnt vmcnt(0)" ::: "memory");
            const unsigned og = xb_add(&bar[XB_TOP], 1u);
            const unsigned tg = og / nx;
            if (og + 1u == (tg + 1u) * nx) xb_add(&bar[XB_TOPGEN], 1u);
            else XB_SPIN(xb_ld(&bar[XB_TOPGEN]) == tg, bar);
            __builtin_amdgcn_fence(__ATOMIC_ACQUIRE, "agent");
            xb_add(&bar[XB_XGEN(b.x)], 1u);
            asm volatile("s_waitcnt vmcnt(0)" ::: "memory");
        } else {
            XB_SPIN(xb_ld(&bar[XB_XGEN(b.x)]) == gen, bar);
            __builtin_amdgcn_fence(__ATOMIC_ACQUIRE, "agent");
            asm volatile("s_waitcnt vmcnt(0)" ::: "memory");
        }
    }
    __syncthreads();
}
template <int MAP> __device__ __forceinline__ int dest_row(int n, int aux) {
    if (MAP == 1) { if (n >= 1280) return n; const int hb = n & ~127, d = n & 127, dd = d & 63; return hb + 32 * (dd >> 4) + 8 * ((dd >> 2) & 3) + 4 * (d >> 6) + (dd & 3); }
    if (MAP == 2) return 256 * (n >> 7) + 128 * aux + (n & 127);
    return n;
}
struct TItem { const float* W; bf16raw* WT; int K, N, map, aux, k0, n0; float scale; };
__device__ __forceinline__ int dest_row_rt(int map, int n, int aux) { return map == 1 ? dest_row<1>(n, aux) : (map == 2 ? dest_row<2>(n, aux) : n); }
__device__ __forceinline__ void titem_load(const TItem& I, float (&t)[32], int lane) {
#pragma unroll
    for (int i = 0; i < 32; ++i) { const int kk = 2 * i + (lane >> 5); t[i] = __builtin_nontemporal_load(I.W + (size_t)(I.k0 + kk) * I.N + I.n0 + (lane & 31)); }
}
__device__ __forceinline__ void titem_store(const TItem& I, const float (&t)[32], LAS float* scr, int lane) {
#pragma unroll
    for (int i = 0; i < 32; ++i) { const int kk = 2 * i + (lane >> 5); scr[kk * 33 + (lane & 31)] = t[i] * I.scale; }
    LDS_WAIT(); asm volatile("" ::: "memory");
    const int c = lane & 7;
#pragma unroll
    for (int j = 0; j < 4; ++j) { const int n = (lane >> 3) + 8 * j; const LAS float* s = scr + (8 * c) * 33 + n;
        v4u o; o.x = pk2(s[0 * 33], s[1 * 33]); o.y = pk2(s[2 * 33], s[3 * 33]); o.z = pk2(s[4 * 33], s[5 * 33]); o.w = pk2(s[6 * 33], s[7 * 33]);
        *(v4u*)(I.WT + (size_t)dest_row_rt(I.map, I.n0 + n, I.aux) * I.K + I.k0 + 8 * c) = o; }
    LDS_WAIT(); asm volatile("" ::: "memory");
}
struct Ptrs {
    const float* in[22]; float* out; unsigned char* ws;
};
constexpr int PI_IN = 16 * (NIN / 32), PI_SQ = 16 * 32, PI_G = 2 * 4, PI_E = 16 * 16;
constexpr int PN_IN = DEPTH * PI_IN, PN_SQ = DEPTH * PI_SQ, PN_G = DEPTH * 16 * PI_G, PN_E = DEPTH * NEXP * PI_E;
constexpr int P_NITEMS = PN_IN + 3 * PN_SQ + 2 * PN_G + 3 * PN_E;
struct TSrc { const float *w_in, *w_rec, *w_ing, *w_ao, *w_ro, *w_out, *w_eg, *w_eu, *w_ed; unsigned char* ws; };
__device__ __forceinline__ TItem titem_decode(const TSrc& P, int it) {
    TItem I; I.map = 0; I.aux = 0; I.scale = 1.f; int r = it, item;
    if (r < PN_IN) { const int l = r / PI_IN; I.W = P.w_in + (size_t)l * DM * NIN; I.K = DM; I.N = NIN; I.WT = (bf16raw*)(P.ws + WS_WIN) + (size_t)l * NIN * DM; I.map = 1; item = r % PI_IN; }
    else if ((r -= PN_IN) < PN_SQ) { const int l = r / PI_SQ; I.W = P.w_ao + (size_t)l * DM * DM; I.K = DM; I.N = DM; I.WT = (bf16raw*)(P.ws + WS_WAO) + (size_t)l * DM * DM; item = r % PI_SQ; }
    else if ((r -= PN_SQ) < PN_SQ) { const int l = r / PI_SQ; I.W = P.w_ro + (size_t)l * DM * DM; I.K = DM; I.N = DM; I.WT = (bf16raw*)(P.ws + WS_WRO) + (size_t)l * DM * DM; item = r % PI_SQ; }
    else if ((r -= PN_SQ) < PN_SQ) { const int l = r / PI_SQ; I.W = P.w_out + (size_t)l * DM * DM; I.K = DM; I.N = DM; I.WT = (bf16raw*)(P.ws + WS_WOUT) + (size_t)l * DM * DM; item = r % PI_SQ; }
    else if ((r -= PN_SQ) < 2 * PN_G) { const int gate = r >= PN_G ? 1 : 0; r -= gate * PN_G; const int mat = r / PI_G;
        const int l = mat >> 4, dir = (mat >> 3) & 1, n = mat & 7;
        if (gate) I.W = P.w_ing + (size_t)mat * 16384; else I.W = P.w_rec + (size_t)mat * 16384;
        I.K = 128; I.N = 128; I.WT = (bf16raw*)(P.ws + WS_WG) + ((size_t)((l * 2 + dir) * 2 + gate) * 8 + n) * 16384; I.scale = -1.4426950408889634f; item = r % PI_G; }
    else if ((r -= 2 * PN_G) < PN_E) { const int le = r / PI_E; I.W = P.w_eg + (size_t)le * DM * DEXP; I.K = DM; I.N = DEXP; I.WT = (bf16raw*)(P.ws + WS_WGU) + (size_t)le * 1024 * DM; I.map = 2; I.aux = 0; item = r % PI_E; }
    else if ((r -= PN_E) < PN_E) { const int le = r / PI_E; I.W = P.w_eu + (size_t)le * DM * DEXP; I.K = DM; I.N = DEXP; I.WT = (bf16raw*)(P.ws + WS_WGU) + (size_t)le * 1024 * DM; I.map = 2; I.aux = 1; item = r % PI_E; }
    else { r -= PN_E; const int le = r / PI_E; I.W = P.w_ed + (size_t)le * DEXP * DM; I.K = DEXP; I.N = DM; I.WT = (bf16raw*)(P.ws + WS_WD) + (size_t)le * DM * DEXP; item = r % PI_E; }
    const int nblk = I.N / 32; I.k0 = 64 * (item / nblk); I.n0 = 32 * (item % nblk);
    return I;
}
__device__ __forceinline__ void p0_prologue(const Ptrs& P, LAS unsigned char* lds, int vcu, int G, int wave, int lane) {
    LAS float* scr = (LAS float*)(lds + wave * 16384);
    const int gw = vcu * NWAVES + wave, NGW = G * NWAVES;
    {
        const TSrc TS{P.in[1], P.in[5], P.in[7], P.in[10], P.in[11], P.in[12], P.in[19], P.in[20], P.in[21], P.ws};
        int it = gw;
        if (it < P_NITEMS) {
            TItem cur = titem_decode(TS, it); float t[32]; titem_load(cur, t, lane);
#pragma unroll 1
            for (;;) {
                const int itn = it + NGW; const bool more = itn < P_NITEMS;
                const TItem nxt = titem_decode(TS, more ? itn : it); float tn[32];
                titem_load(nxt, tn, lane);
                titem_store(cur, t, scr, lane);
                if (!more) break;
                cur = nxt; it = itn;
#pragma unroll
                for (int i = 0; i < 32; ++i) t[i] = tn[i];
            }
        }
    }
    const int gt = gw * 64 + lane, NGT = NGW * 64;
    float* rc = (float*)(P.ws + WS_RCOS); float* rs = (float*)(P.ws + WS_RSIN);
    for (int i = gt; i < SEQ * 64; i += NGT) { const int t = i >> 6, f = i & 63;
        const float inv = (float)pow(10000.0, -(double)f / 64.0); const float ang = (float)t * inv;
        rc[i] = (float)cos((double)ang); rs[i] = (float)sin((double)ang); }
    float* sp = (float*)(P.ws + WS_SP);
    for (int i = gt; i < DEPTH * 2 * 1024; i += NGT) { const double lam = (double)P.in[9][i]; sp[i] = (float)(8.0 * log1p(exp(-lam))); }
    bf16raw* wrh = (bf16raw*)(P.ws + WS_WR); bf16raw* wrl = wrh + (size_t)DEPTH * 48 * 1024;
    for (int i = gt; i < DEPTH * 48 * 1024; i += NGT) { const int l = i / (48 * 1024), o = (i / 1024) % 48, k = i & 1023;
        const float w = o < 4 ? P.in[15][((size_t)l * 1024 + k) * 4 + o] : (o < 36 ? P.in[17][((size_t)l * 1024 + k) * 32 + (o - 4)] : 0.f);
        const unsigned h = f2bf(w); wrh[i] = (bf16raw)h; wrl[i] = (bf16raw)f2bf(w - __builtin_bit_cast(float, h << 16)); }
    bf16raw* XB = (bf16raw*)(P.ws + WS_XB);
    for (int i = gt; i < TOK * DM / 8; i += NGT) { const f32x4 a = *(const f32x4*)(P.in[0] + (size_t)i * 8), b = *(const f32x4*)(P.in[0] + (size_t)i * 8 + 4);
        v4u o; o.x = pk2(a[0], a[1]); o.y = pk2(a[2], a[3]); o.z = pk2(b[0], b[1]); o.w = pk2(b[2], b[3]); *(v4u*)(XB + (size_t)i * 8) = o; }
}

constexpr int XC_LD = 272;
constexpr int SCAN_XC = 0, SCAN_OUT = 128 * XC_LD, OUT_LD = 528;
typedef float f32x4s __attribute__((ext_vector_type(4)));
__device__ __forceinline__ int xc_off(int row, int chunk) { return row * XC_LD + (((chunk + 4 * (row >> 4)) & 15) << 4); }
constexpr int SCAN_CW = SCAN_OUT + 128 * OUT_LD;
constexpr int LDS_CARRY = 131072 + 1024;
__device__ __forceinline__ void carry_prep(const Ptrs& P, LAS unsigned char* lds, int vcu, int G, int tid) {
    const f32x2* SUMM = (const f32x2*)(P.ws + WS_SUMM);
#pragma unroll 1
    for (int k2 = 0; k2 < 2; ++k2) {
        const int idx = tid + NTHREADS * k2, ui = idx >> 8, dir = (idx >> 7) & 1, chn = idx & 127;
        const int id = vcu + G * ui, b = id >> 9, ch = (id >> 3) & 63, n = id & 7, gc = n * 128 + chn;
        const int nlist = dir == 0 ? ch : (NCHUNK - 1 - ch);
        const f32x2* base = SUMM + ((size_t)((b * 2 + dir) * NCHUNK)) * 1024 + gc;
        float carry = 0.f;
#pragma unroll 1
        for (int i0 = 0; i0 < nlist; i0 += 16) {
            f32x2 s[16];
#pragma unroll
            for (int i = 0; i < 16; ++i) { const int ii = i0 + i; const int ic = ii < NCHUNK ? ii : NCHUNK - 1; const int c2 = dir == 0 ? ic : (NCHUNK - 1 - ic); s[i] = base[(size_t)c2 * 1024]; }
#pragma unroll
            for (int i = 0; i < 16; ++i) { if (i0 + i < nlist) carry = s[i].x * carry + s[i].y; }
        }
        ((LAS float*)(lds + LDS_CARRY))[idx] = carry;
    }
}
template <bool PASS2>
__device__ __forceinline__ void scan_phase(const Ptrs& P, LAS unsigned char* lds, int l, int vcu, int G, int tid, int wave, int lane) {
    const bf16raw* XR = (const bf16raw*)(P.ws + WS_XR);
    const int n = vcu & 7;
    const int col = lane & 15, q = lane >> 4, dcol = 16 * wave + col, gc = n * 128 + dcol;
    const int cg = tid & 15, tl = tid >> 4, c0 = n * 128 + cg * 8;
    if (tid < 160) { const int g2 = tid / 10, part = tid % 10;
        const float* src = part < 8 ? P.in[3] + (size_t)l * 4 * 1024 + (part >> 1) * 1024 + n * 128 + g2 * 8 + (part & 1) * 4 : P.in[4] + (size_t)l * 1024 + n * 128 + g2 * 8 + (part & 1) * 4;
        *(LAS f32x4*)(lds + SCAN_CW + (g2 * 40 + part * 4) * 4) = *(const f32x4*)src; }
    const bf16raw* WG = (const bf16raw*)(P.ws + WS_WG);
    bf16x8 Bf[2][2][4];
    float br[2], bi[2], nsp2[2];
#pragma unroll
    for (int dir = 0; dir < 2; ++dir) {
#pragma unroll
        for (int gate = 0; gate < 2; ++gate)
#pragma unroll
            for (int ks = 0; ks < 4; ++ks) Bf[dir][gate][ks] = *(const bf16x8*)(WG + (((size_t)((l * 2 + dir) * 2 + gate) * 8 + n) * 128 + dcol) * 128 + 32 * ks + 8 * q);
        br[dir] = -1.4426950408889634f * P.in[6][(size_t)(l * 2 + dir) * 1024 + gc]; bi[dir] = -1.4426950408889634f * P.in[8][(size_t)(l * 2 + dir) * 1024 + gc];
        nsp2[dir] = -1.4426950408889634f * ((const float*)(P.ws + WS_SP))[(size_t)(l * 2 + dir) * 1024 + gc];
    }
    bf16x8 Bsel;
    { const int jt = 16 * (wave & 1) + col - 8 * q; v4u w;
      w.x = (jt == 0 ? 0x3F80u : 0u) | (jt == 1 ? 0x3F800000u : 0u); w.y = (jt == 2 ? 0x3F80u : 0u) | (jt == 3 ? 0x3F800000u : 0u);
      w.z = (jt == 4 ? 0x3F80u : 0u) | (jt == 5 ? 0x3F800000u : 0u); w.w = (jt == 6 ? 0x3F80u : 0u) | (jt == 7 ? 0x3F800000u : 0u);
      Bsel = __builtin_bit_cast(bf16x8, w); }
    const int wsel = wave >> 1;
    v4u xraw[7];
#define SCAN_LOAD_ROWS(unit_id) do { const int b_ = (unit_id) >> 9, t0_ = (((unit_id) >> 3) & 63) * CHUNK; _Pragma("unroll") for (int i = 0; i < 7; ++i) { const int t = t0_ + 4 * tl - 2 + i; const int tc = t < 0 ? 0 : (t >= SEQ ? SEQ - 1 : t); \
        v4u raw_ = *(const v4u*)(XR + ((size_t)(b_ * SEQ + tc)) * 1024 + c0); if (t != tc) raw_ = (v4u){0u, 0u, 0u, 0u}; xraw[i] = raw_; } } while (0)
    SCAN_LOAD_ROWS(vcu);
    __syncthreads();
#pragma unroll 1
    for (int k = 0; k < 4; ++k) {
        const int id = vcu + G * k, b = id >> 9, ch = (id >> 3) & 63, t0 = ch * CHUNK;
        v4u ygv[4];
        {
            float w[4][8], bb[8];
            const LAS f32x4* cw = (const LAS f32x4*)(lds + SCAN_CW + cg * 160);
#pragma unroll
            for (int tap = 0; tap < 4; ++tap) { const f32x4 a = cw[2 * tap], c = cw[2 * tap + 1];
                w[tap][0] = a[0]; w[tap][1] = a[1]; w[tap][2] = a[2]; w[tap][3] = a[3]; w[tap][4] = c[0]; w[tap][5] = c[1]; w[tap][6] = c[2]; w[tap][7] = c[3]; }
            { const f32x4 a = cw[8], c = cw[9]; bb[0] = a[0]; bb[1] = a[1]; bb[2] = a[2]; bb[3] = a[3]; bb[4] = c[0]; bb[5] = c[1]; bb[6] = c[2]; bb[7] = c[3]; }
            float xv[7][8];
#pragma unroll
            for (int i = 0; i < 7; ++i) { const v4u raw = xraw[i];
                xv[i][0] = bflo(raw.x); xv[i][1] = bfhi(raw.x); xv[i][2] = bflo(raw.y); xv[i][3] = bfhi(raw.y); xv[i][4] = bflo(raw.z); xv[i][5] = bfhi(raw.z); xv[i][6] = bflo(raw.w); xv[i][7] = bfhi(raw.w); }
#pragma unroll
            for (int j = 0; j < 4; ++j) { float o[8];
#pragma unroll
                for (int e = 0; e < 8; ++e) o[e] = bb[e] + w[0][e] * xv[j][e] + w[1][e] * xv[j + 1][e] + w[2][e] * xv[j + 2][e] + w[3][e] * xv[j + 3][e];
                v4u pk; pk.x = pk2(o[0], o[1]); pk.y = pk2(o[2], o[3]); pk.z = pk2(o[4], o[5]); pk.w = pk2(o[6], o[7]);
                *(LAS v4u*)(lds + SCAN_XC + xc_off(4 * tl + j, cg)) = pk; }
        }
        __syncthreads();
        if (k + 1 < 4) SCAN_LOAD_ROWS(vcu + G * (k + 1));
#if defined(SCAN_CREP)
#pragma unroll 1
        for (int crep = 0; crep < SCAN_CREP; ++crep)
#endif
#pragma unroll
        for (int dir = 0; dir < 2; ++dir) {
            float carry = 0.f, atot = 1.f, prun = 1.f;
            const float cdir = PASS2 ? ((const LAS float*)(lds + LDS_CARRY))[(k * 2 + dir) * 128 + dcol] : 0.f;
#pragma unroll 1
            for (int hh = 0; hh < 2; ++hh) {
                const int tb = 64 * (dir == 0 ? hh : 1 - hh);
                float e1[16], e2[16], xq[16];
#pragma unroll
                for (int i = 0; i < 4; ++i) {
                    const int row = tb + 16 * (col >> 2) + 4 * i + (col & 3);
                    f32x4s accr = {br[dir], br[dir], br[dir], br[dir]}, acci = {bi[dir], bi[dir], bi[dir], bi[dir]}, accx = {0.f, 0.f, 0.f, 0.f};
#pragma unroll
                    for (int ks = 0; ks < 4; ++ks) { const bf16x8 a = *(const LAS bf16x8*)(lds + SCAN_XC + xc_off(row, 4 * ks + q));
                        accr = __builtin_amdgcn_mfma_f32_16x16x32_bf16(a, Bf[dir][0][ks], accr, 0, 0, 0);
                        if (!PASS2) acci = __builtin_amdgcn_mfma_f32_16x16x32_bf16(a, Bf[dir][1][ks], acci, 0, 0, 0); }
                    if (!PASS2) { const bf16x8 a = *(const LAS bf16x8*)(lds + SCAN_XC + xc_off(row, 4 * wsel + q)); accx = __builtin_amdgcn_mfma_f32_16x16x32_bf16(a, Bsel, accx, 0, 0, 0); }
#pragma unroll
                    for (int j = 0; j < 4; ++j) { e1[4 * i + j] = accr[j]; e2[4 * i + j] = acci[j]; xq[4 * i + j] = accx[j]; }
                }
                float av[16], uv[16];
#pragma unroll
                for (int t = 0; t < 16; ++t) { e1[t] = __builtin_amdgcn_exp2f(e1[t]); if (!PASS2) e2[t] = __builtin_amdgcn_exp2f(e2[t]); }
#pragma unroll
                for (int t = 0; t < 16; ++t) { e1[t] = __builtin_amdgcn_rcpf(1.f + e1[t]); if (!PASS2) e2[t] = __builtin_amdgcn_rcpf(1.f + e2[t]); }
#pragma unroll
                for (int t = 0; t < 16; ++t) av[t] = __builtin_amdgcn_exp2f(nsp2[dir] * e1[t]);
                if (!PASS2) {
#pragma unroll
                    for (int t = 0; t < 16; ++t) uv[t] = xq[t] * e2[t] * __builtin_amdgcn_sqrtf(__builtin_fmaf(-av[t], av[t], 1.f));
                }
                float Pc[16], Sc[16];
                if (dir == 0) { Pc[0] = av[0]; if (!PASS2) Sc[0] = uv[0];
#pragma unroll
                    for (int t = 1; t < 16; ++t) { Pc[t] = Pc[t - 1] * av[t]; if (!PASS2) Sc[t] = av[t] * Sc[t - 1] + uv[t]; } }
                else { Pc[15] = av[15]; if (!PASS2) Sc[15] = uv[15];
#pragma unroll
                    for (int t = 14; t >= 0; --t) { Pc[t] = Pc[t + 1] * av[t]; if (!PASS2) Sc[t] = av[t] * Sc[t + 1] + uv[t]; } }
                const float Pa = dir == 0 ? Pc[15] : Pc[0];
                if (!PASS2) {
                    const float Sa = dir == 0 ? Sc[15] : Sc[0];
                    float hs = carry, run = carry;
#pragma unroll
                    for (int k2 = 0; k2 < 4; ++k2) { const int qq = dir == 0 ? k2 : 3 - k2;
                        const float Ak = bperm_f(col + 16 * qq, Pa), Hk = bperm_f(col + 16 * qq, Sa);
                        if (qq == q) hs = run;
                        run = Ak * run + Hk; atot *= Ak; }
                    carry = run;
#pragma unroll
                    for (int t = 0; t < 16; ++t) { const float h = Sc[t] + Pc[t] * hs;
                        LAS float* op = (LAS float*)(lds + SCAN_OUT + (tb + 16 * q + t) * OUT_LD + dcol * 4);
                        if (dir == 0) *op = h; else *op = *op + h; }
                } else {
                    float pq = prun;
#pragma unroll
                    for (int k2 = 0; k2 < 4; ++k2) { const int qq = dir == 0 ? k2 : 3 - k2;
                        const float Ak = bperm_f(col + 16 * qq, Pa);
                        if (qq == q) pq = prun;
                        prun *= Ak; }
                    const float sc = pq * cdir;
#pragma unroll
                    for (int t = 0; t < 16; ++t) { const float h = Pc[t] * sc;
                        LAS float* op = (LAS float*)(lds + SCAN_OUT + (tb + 16 * q + t) * OUT_LD + dcol * 4);
                        if (dir == 0) *op = h; else *op = *op + h; }
                }
            }
            if (!PASS2) { if (q == 0) ((f32x2*)(P.ws + WS_SUMM))[((size_t)((b * 2 + dir) * NCHUNK + ch)) * 1024 + gc] = (f32x2){atot, carry}; }
        }
        if (!PASS2) {
            __syncthreads();
            bf16raw* SS = (bf16raw*)(P.ws + WS_SS);
#pragma unroll
            for (int j = 0; j < 4; ++j) { const int t = t0 + 4 * tl + j; const size_t go = ((size_t)(b * SEQ + t)) * 1024 + c0;
                const f32x4 h0 = *(const LAS f32x4*)(lds + SCAN_OUT + (4 * tl + j) * OUT_LD + cg * 32), h1 = *(const LAS f32x4*)(lds + SCAN_OUT + (4 * tl + j) * OUT_LD + cg * 32 + 16);
                v4u o; o.x = pk2(h0[0], h0[1]); o.y = pk2(h0[2], h0[3]); o.z = pk2(h1[0], h1[1]); o.w = pk2(h1[2], h1[3]);
                *(v4u*)(SS + go) = o; }
        } else {
            v4u ssv[4];
            { const bf16raw* YGp = (const bf16raw*)(P.ws + WS_YG); const bf16raw* SSp = (const bf16raw*)(P.ws + WS_SS);
#pragma unroll
              for (int j = 0; j < 4; ++j) { const size_t go = ((size_t)(b * SEQ + t0 + 4 * tl + j)) * 1024 + c0; ygv[j] = *(const v4u*)(YGp + go); ssv[j] = *(const v4u*)(SSp + go); } }
            __syncthreads();
            bf16raw* HG = (bf16raw*)(P.ws + WS_HG);
#pragma unroll
            for (int j = 0; j < 4; ++j) { const int t = t0 + 4 * tl + j; const size_t go = ((size_t)(b * SEQ + t)) * 1024 + c0;
                const f32x4 h0 = *(const LAS f32x4*)(lds + SCAN_OUT + (4 * tl + j) * OUT_LD + cg * 32), h1 = *(const LAS f32x4*)(lds + SCAN_OUT + (4 * tl + j) * OUT_LD + cg * 32 + 16); const v4u yv = ygv[j], sv = ssv[j];
                v4u o; o.x = pk2((h0[0] + bflo(sv.x)) * bflo(yv.x), (h0[1] + bfhi(sv.x)) * bfhi(yv.x)); o.y = pk2((h0[2] + bflo(sv.y)) * bflo(yv.y), (h0[3] + bfhi(sv.y)) * bfhi(yv.y));
                o.z = pk2((h1[0] + bflo(sv.z)) * bflo(yv.z), (h1[1] + bfhi(sv.z)) * bfhi(yv.z)); o.w = pk2((h1[2] + bflo(sv.w)) * bflo(yv.w), (h1[3] + bfhi(sv.w)) * bfhi(yv.w));
                *(v4u*)(HG + go) = o; }
        }
        __syncthreads();
    }
#undef SCAN_LOAD_ROWS
}

constexpr int RT_XH = 0, RT_XL = 65536;
constexpr int RT_PART = 0, RT_LOGIT = 49152;
__device__ __forceinline__ void ln1_router_phase(const Ptrs& P, LAS unsigned char* lds, int l, int vcu, int G, int tid, int wave, int lane) {
    const float* X1 = (const float*)(P.ws + WS_X1); float* X1O = P.out;
    bf16raw* XB = (bf16raw*)(P.ws + WS_XB);
    const float* gam = P.in[13] + (size_t)(l * 2 + 0) * 1024; const float* bet = P.in[14] + (size_t)(l * 2 + 0) * 1024;
    const bf16raw* WRH = (const bf16raw*)(P.ws + WS_WR) + (size_t)l * 48 * 1024; const bf16raw* WRL = WRH + (size_t)DEPTH * 48 * 1024;
    LAS int* lcnt = (LAS int*)(lds + LDS_CARRY);
    if (tid < NEXP) lcnt[tid] = 0;
    LAS int* lbase = lcnt + 32; LAS int* rt_e = lcnt + 64; LAS int* rt_p = lcnt + 192; LAS float* rt_w = (LAS float*)(lcnt + 320);
    f32x4 gv[4], bv[4];
#pragma unroll
    for (int j = 0; j < 4; ++j) { gv[j] = *(const f32x4*)(gam + 4 * lane + 256 * j); bv[j] = *(const f32x4*)(bet + 4 * lane + 256 * j); }
    const int col = lane & 15, q = lane >> 4;
#pragma unroll 1
    for (int pass = 0; pass < 2; ++pass) {
        const int mb = vcu * 64 + pass * 32;
#pragma unroll
        for (int r = 0; r < 4; ++r) {
            const int lr = wave * 4 + r; const size_t go = (size_t)(mb + lr) * 1024;
            f32x4 x[4]; float s = 0.f;
#pragma unroll
            for (int j = 0; j < 4; ++j) { x[j] = *(const f32x4*)(X1 + go + 4 * lane + 256 * j); s += (x[j][0] + x[j][1]) + (x[j][2] + x[j][3]); }
            const float mean = wave_sum(s) * (1.f / 1024.f); float s2 = 0.f;
#pragma unroll
            for (int j = 0; j < 4; ++j) { x[j] = x[j] - mean; s2 += (x[j][0] * x[j][0] + x[j][1] * x[j][1]) + (x[j][2] * x[j][2] + x[j][3] * x[j][3]); }
            const float rstd = 1.f / sqrtf(wave_sum(s2) * (1.f / 1024.f) + LN_EPS);
#pragma unroll
            for (int j = 0; j < 4; ++j) { x[j] = x[j] * rstd * gv[j] + bv[j];
                *(f32x4*)(X1O + go + 4 * lane + 256 * j) = x[j];
                const unsigned h0 = f2bf(x[j][0]), h1 = f2bf(x[j][1]), h2 = f2bf(x[j][2]), h3 = f2bf(x[j][3]);
                v2u hv; hv.x = h0 | (h1 << 16); hv.y = h2 | (h3 << 16);
                *(v2u*)(XB + go + 4 * lane + 256 * j) = hv;
                v2u lv; lv.x = pk2(x[j][0] - __builtin_bit_cast(float, h0 << 16), x[j][1] - __builtin_bit_cast(float, h1 << 16)); lv.y = pk2(x[j][2] - __builtin_bit_cast(float, h2 << 16), x[j][3] - __builtin_bit_cast(float, h3 << 16));
                const int off = lr * 2048 + (((32 * j + (lane >> 1)) ^ (lr & 15)) << 4) + (lane & 1) * 8;
                *(LAS v2u*)(lds + RT_XH + off) = hv; *(LAS v2u*)(lds + RT_XL + off) = lv; }
        }
        bf16x8 Bh[4][3], Bl[4][3];
#pragma unroll
        for (int ks = 0; ks < 4; ++ks)
#pragma unroll
            for (int nt = 0; nt < 3; ++nt) { const size_t wo = (size_t)(16 * nt + col) * 1024 + 32 * (wave * 4 + ks) + 8 * q;
                Bh[ks][nt] = *(const bf16x8*)(WRH + wo); Bl[ks][nt] = *(const bf16x8*)(WRL + wo); }
        __syncthreads();
        f32x4 acc[2][3];
#pragma unroll
        for (int m = 0; m < 2; ++m)
#pragma unroll
            for (int nt = 0; nt < 3; ++nt) acc[m][nt] = (f32x4){0.f, 0.f, 0.f, 0.f};
#pragma unroll
        for (int ks = 0; ks < 4; ++ks)
#pragma unroll
            for (int m = 0; m < 2; ++m) { const int row = 16 * m + col; const int off = row * 2048 + (((4 * (wave * 4 + ks) + q) ^ (row & 15)) << 4);
                const bf16x8 ah = *(const LAS bf16x8*)(lds + RT_XH + off), al = *(const LAS bf16x8*)(lds + RT_XL + off);
#pragma unroll
                for (int nt = 0; nt < 3; ++nt) { acc[m][nt] = __builtin_amdgcn_mfma_f32_16x16x32_bf16(ah, Bh[ks][nt], acc[m][nt], 0, 0, 0);
                    acc[m][nt] = __builtin_amdgcn_mfma_f32_16x16x32_bf16(al, Bh[ks][nt], acc[m][nt], 0, 0, 0);
                    acc[m][nt] = __builtin_amdgcn_mfma_f32_16x16x32_bf16(ah, Bl[ks][nt], acc[m][nt], 0, 0, 0); } }
        __syncthreads();
#pragma unroll
        for (int m = 0; m < 2; ++m)
#pragma unroll
            for (int nt = 0; nt < 3; ++nt) *(LAS f32x4*)(lds + RT_PART + ((wave * 6 + m * 3 + nt) * 256 + lane * 4) * 4) = acc[m][nt];
        __syncthreads();
#pragma unroll
        for (int i = 0; i < 3; ++i) { const int idx = tid + NTHREADS * i, t = idx >> 8, p = idx & 255; float s = 0.f;
#pragma unroll
            for (int w = 0; w < 8; ++w) s += *(const LAS float*)(lds + RT_PART + ((w * 6 + t) * 256 + p) * 4);
            const int ll = p >> 2, j = p & 3, token = 16 * (t / 3) + 4 * (ll >> 4) + j, o = 16 * (t % 3) + (ll & 15);
            const float bias = o < 4 ? P.in[16][l * 4 + o] : (o < 36 ? P.in[18][l * 32 + o - 4] : 0.f);
            *(LAS float*)(lds + RT_LOGIT + (token * 48 + o) * 4) = s + bias; }
        __syncthreads();
        if (tid < 32) {
            const LAS float* lg = (const LAS float*)(lds + RT_LOGIT + tid * 192);
            int gi = 0; float gm = lg[0];
#pragma unroll
            for (int k = 1; k < 4; ++k) { const float v = lg[k]; if (v > gm) { gm = v; gi = k; } }
            float den = 0.f;
#pragma unroll
            for (int k = 0; k < 4; ++k) den += expf(lg[k] - gm);
            const float gval = 1.f / den;
            const LAS float* eg = lg + 4 + 8 * gi;
            int i1 = 0; float v1 = eg[0];
#pragma unroll
            for (int k = 1; k < 8; ++k) { const float v = eg[k]; if (v > v1) { v1 = v; i1 = k; } }
            int i2 = -1; float v2 = 0.f;
#pragma unroll
            for (int k = 0; k < 8; ++k) { const float v = eg[k]; if (k != i1 && (i2 < 0 || v > v2)) { v2 = v; i2 = k; } }
            const float ex = expf(v2 - v1), w1 = gval / (1.f + ex), w2 = gval * ex / (1.f + ex);
            const int m = mb + tid, e1 = gi * 8 + i1, e2 = gi * 8 + i2;
            const int p1 = __hip_atomic_fetch_add(lcnt + e1, 1, __ATOMIC_RELAXED, __HIP_MEMORY_SCOPE_WORKGROUP), p2 = __hip_atomic_fetch_add(lcnt + e2, 1, __ATOMIC_RELAXED, __HIP_MEMORY_SCOPE_WORKGROUP);
            const int la = 2 * (pass * 32 + tid); (void)m;
            rt_e[la] = e1; rt_p[la] = p1; rt_w[la] = w1; rt_e[la + 1] = e2; rt_p[la + 1] = p2; rt_w[la + 1] = w2;
        }
        __syncthreads();
    }
    if (tid < NEXP) lbase[tid] = (int)atomicAdd((unsigned*)(P.ws + WS_CTL) + CW_CNT + l * 2048 + tid * 64, (unsigned)lcnt[tid]);
    __syncthreads();
    if (tid < 128) { const int e = rt_e[tid], p = lbase[e] + rt_p[tid];
        ((int*)(P.ws + WS_SLOT2))[e * pg8::MOE_CAP + p] = vcu * 128 + tid; ((float*)(P.ws + WS_ROWW2))[e * pg8::MOE_CAP + p] = rt_w[tid]; }
    __syncthreads();
}
constexpr int MT_CNT = 0, MT_TFIRST = 32, MT_TILEE = 128, MT_NT = 320;
__device__ __forceinline__ int moe_tables(const Ptrs& P, LAS unsigned char* lds, int l, int tid) {
    LAS int* T = (LAS int*)(lds + LDS_CARRY);
    if (tid < NEXP) T[MT_CNT + tid] = (int)__hip_atomic_load((unsigned*)(P.ws + WS_CTL) + CW_CNT + l * 2048 + tid * 64, __ATOMIC_RELAXED, __HIP_MEMORY_SCOPE_AGENT);
    __syncthreads();
    if (tid == 0) { int t = 0;
#pragma unroll 1
        for (int e = 0; e < NEXP; ++e) { T[MT_TFIRST + e] = t; const int nt = (T[MT_CNT + e] + 255) >> 8;
#pragma unroll 1
            for (int i = 0; i < nt; ++i) T[MT_TILEE + t + i] = e;
            t += nt; }
        T[MT_TFIRST + NEXP] = t; T[MT_NT] = t; }
    __syncthreads();
    return T[MT_NT];
}
__device__ __forceinline__ void gather_phase(const Ptrs& P, LAS unsigned char* lds, int l, int vcu, int G, int tid, int wave, int lane) {
    LAS int* ps = (LAS int*)lds;
    const int* blkcnt = (const int*)(P.ws + WS_ROUTE + RT_BLKCNT);
    { const int e = tid & 31, part = tid >> 5; int tot = 0, pre = 0;
#pragma unroll
        for (int i = 0; i < 16; ++i) { const int b2 = part * 16 + i; const int c = blkcnt[b2 * NEXP + e]; tot += c; pre += b2 < vcu ? c : 0; }
        ps[256 + part * 32 + e] = tot; ps[768 + part * 32 + e] = pre; }
    __syncthreads();
    if (tid < NEXP) { int tot = 0, pre = 0;
#pragma unroll
        for (int p2 = 0; p2 < 16; ++p2) { tot += ps[256 + p2 * 32 + tid]; pre += ps[768 + p2 * 32 + tid]; }
        ps[64 + tid] = tot; ps[128 + tid] = pre; }
    __syncthreads();
    if (tid == 0) { int acc = 0; for (int e = 0; e < NEXP; ++e) { ps[e] = acc; acc += (ps[64 + e] + 255) & ~255; } ps[32] = acc; }
    __syncthreads();
    const int* tok_e = (const int*)(P.ws + WS_ROUTE + RT_TOKE); const int* tok_pos = (const int*)(P.ws + WS_ROUTE + RT_TOKPOS); const float* tok_w = (const float*)(P.ws + WS_ROUTE + RT_TOKW);
    int* slot = (int*)(P.ws + WS_ROUTE + RT_SLOT); float* roww = (float*)(P.ws + WS_ROUTE + RT_ROWW); int* tile_e = (int*)(P.ws + WS_ROUTE + RT_TILEE);
    const bf16raw* XB = (const bf16raw*)(P.ws + WS_XB); bf16raw* XS = (bf16raw*)(P.ws + WS_XS);
    for (int i = 0; i < 16; ++i) { const int a = vcu * 128 + wave * 16 + i;
        const int e = tok_e[a], dest = ps[e] + ps[128 + e] + tok_pos[a];
        const v4u* src = (const v4u*)(XB + (size_t)(a >> 1) * 1024); v4u* dst = (v4u*)(XS + (size_t)dest * 1024);
        const v4u a0 = src[lane], a1 = src[64 + lane]; dst[lane] = a0; dst[64 + lane] = a1;
        if (lane == 0) { slot[dest] = a; roww[dest] = tok_w[a]; }
    }
    const int total = ps[32];
    for (int r = (vcu * NTHREADS + tid); r < total; r += G * NTHREADS) {
        int e = 0;
#pragma unroll 1
        for (int k = 1; k < NEXP; ++k) if (r >= ps[k]) e = k;
        if (r - ps[e] >= ps[64 + e]) { slot[r] = -1; roww[r] = 0.f; }
    }
    if (vcu == 0) {
        const int nt = total >> 8;
        for (int t = tid; t < nt; t += NTHREADS) { int e = 0;
#pragma unroll 1
            for (int k = 1; k < NEXP; ++k) if (t * 256 >= ps[k]) e = k;
            tile_e[t] = e; }
        if (tid == 0) tile_e[MOE_TILES_MAX] = nt;
    }
    __syncthreads();
}
__device__ __forceinline__ void ln2_phase(const Ptrs& P, int l, float* dstf, bool use_moe, int vcu, int G, int wave, int lane) {
    const float* X1 = P.out; bf16raw* XB = (bf16raw*)(P.ws + WS_XB); const bf16raw* YB = (const bf16raw*)(P.ws + WS_YB);
    const float* gam = P.in[13] + (size_t)(l * 2 + 1) * 1024; const float* bet = P.in[14] + (size_t)(l * 2 + 1) * 1024;
    const int gw = vcu * NWAVES + wave, NGW = G * NWAVES;
    f32x4 gv[4], bv[4];
#pragma unroll
    for (int j = 0; j < 4; ++j) { gv[j] = *(const f32x4*)(gam + 4 * lane + 256 * j); bv[j] = *(const f32x4*)(bet + 4 * lane + 256 * j); }
    for (int m = gw; m < TOK; m += NGW) {
        f32x4 x[4]; float s = 0.f;
#pragma unroll
        for (int j = 0; j < 4; ++j) { x[j] = *(const f32x4*)(X1 + (size_t)m * 1024 + 4 * lane + 256 * j) * ALPHA;
            if (use_moe) { const v2u y0 = *(const v2u*)(YB + (size_t)(2 * m) * 1024 + 4 * lane + 256 * j), y1 = *(const v2u*)(YB + (size_t)(2 * m + 1) * 1024 + 4 * lane + 256 * j);
                x[j][0] += bflo(y0.x) + bflo(y1.x); x[j][1] += bfhi(y0.x) + bfhi(y1.x); x[j][2] += bflo(y0.y) + bflo(y1.y); x[j][3] += bfhi(y0.y) + bfhi(y1.y); }
            s += (x[j][0] + x[j][1]) + (x[j][2] + x[j][3]); }
        const float mean = wave_sum(s) * (1.f / 1024.f); float s2 = 0.f;
#pragma unroll
        for (int j = 0; j < 4; ++j) { x[j] = x[j] - mean; s2 += (x[j][0] * x[j][0] + x[j][1] * x[j][1]) + (x[j][2] * x[j][2] + x[j][3] * x[j][3]); }
        const float rstd = 1.f / sqrtf(wave_sum(s2) * (1.f / 1024.f) + LN_EPS);
#pragma unroll
        for (int j = 0; j < 4; ++j) { x[j] = x[j] * rstd * gv[j] + bv[j];
            *(f32x4*)(dstf + (size_t)m * 1024 + 4 * lane + 256 * j) = x[j];
            v2u o; o.x = pk2(x[j][0], x[j][1]); o.y = pk2(x[j][2], x[j][3]);
            *(v2u*)(XB + (size_t)m * 1024 + 4 * lane + 256 * j) = o; }
    }
}
__device__ __forceinline__ void resid_only_phase(const Ptrs& P, const float* xin, int vcu, int G, int wave, int lane) {
    float* X1 = (float*)(P.ws + WS_X1); const int gt = (vcu * NWAVES + wave) * 64 + lane, NGT = G * NTHREADS;
    for (int i = gt; i < TOK * DM / 4; i += NGT) *(f32x4*)(X1 + (size_t)i * 4) = *(const f32x4*)(xin + (size_t)i * 4) * ALPHA;
}

constexpr int N_PHASES = 1 + 10 * DEPTH;
#ifndef ONLY_S
#define ONLY_S -1
#endif
#define PH_ON(k) (ONLY_S < 0 || ONLY_S == (k))
#ifndef REP_MASK
#define REP_MASK 0
#endif
#define REPS(bit) (((REP_MASK >> (bit)) & 1) ? 2 : 1)
struct Args { const float* in[22]; float* out; unsigned char* ws; int ph_lo, ph_hi, sub, pad; };

__device__ __forceinline__ attn::BlockRef<attn::bf16, attn::bf16> attn_block(const Ptrs& P, int l, int id) {
    const int hq = id & 3, qb = (id >> 2) & 31, g = (id >> 7) & 1, b = id >> 8;
    attn::BlockRef<attn::bf16, attn::bf16> r;
    const size_t row0 = (size_t)b * SEQ + (size_t)qb * 256;
    r.Q = (const attn::bf16*)(P.ws + WS_Q) + row0 * 1024 + (g * 4 + hq) * 128;
    r.O = (attn::bf16*)(P.ws + WS_AO) + row0 * 1024 + (g * 4 + hq) * 128;
    r.K = (const attn::bf16*)(P.ws + WS_K) + (size_t)b * SEQ * 256 + g * 128;
    r.V = (const attn::bf16*)(P.ws + WS_V) + (size_t)b * SEQ * 256 + g * 128;
    r.P0 = qb * 256; r.sinkl2 = P.in[2][l * 8 + g * 4 + hq] * 1.4426950408889634f;
    return r;
}

__global__ void __launch_bounds__(NTHREADS, 2) fwd_kernel(Args args) {
    extern __shared__ __attribute__((aligned(16))) unsigned char lds_raw[];
    LAS unsigned char* lds = (LAS unsigned char*)lds_raw;
    const int tid0 = threadIdx.x;
    const int G = gridDim.x, bx = blockIdx.x, vcu = (G % 8 == 0) ? (bx % 8) * (G / 8) + bx / 8 : bx;
    const int lo = args.ph_lo, hi = args.ph_hi, sub = args.sub;
    for (int u = tid0; u < (LDS_BYTES - 131072) / 4; u += NTHREADS) ((LAS unsigned*)(lds + 131072))[u] = 0u;
    __syncthreads();
    XcdBarrier bar; bar.bar = (unsigned*)(args.ws + WS_CTL) + CW_BAR; bar.x = 0; bar.st = nullptr;
    if (hi - lo > 1) bar = xcd_barrier_post((unsigned*)(args.ws + WS_CTL) + CW_BAR, (volatile LAS unsigned*)(lds + 131072 + 320) + 8);
    constexpr bool EN_MIX = (EN_ATTN || EN_RNN);

    if (lo == 0) {
        Ptrs P0;
#pragma unroll
        for (int i = 0; i < 22; ++i) P0.in[i] = args.in[i];
        P0.out = args.out; P0.ws = args.ws;
        if (PH_ON(10)) p0_prologue(P0, lds, vcu, G, __builtin_amdgcn_readfirstlane(tid0 >> 6), tid0 & 63);
        if (hi > 1) xcd_barrier(bar);
    }
    for (int ph = (lo == 0 ? 1 : lo); ph < hi; ++ph) {
        int tid_ = threadIdx.x; asm volatile("" : "+v"(tid_));
        const int tid = tid_, lane = tid & 63, wave = __builtin_amdgcn_readfirstlane(tid >> 6);
        const __attribute__((address_space(4))) unsigned char* kap = (const __attribute__((address_space(4))) unsigned char*)__builtin_amdgcn_kernarg_segment_ptr();
        asm volatile("" : "+s"(kap));
        const __attribute__((address_space(4))) Args* ap = (const __attribute__((address_space(4))) Args*)kap;
        Ptrs P;
#pragma unroll
        for (int i = 0; i < 22; ++i) P.in[i] = ap->in[i];
        P.out = ap->out; P.ws = ap->ws;
        unsigned char* ws = P.ws;
        bf16raw* XB = (bf16raw*)(ws + WS_XB); float* X1 = (float*)(ws + WS_X1); float* XRES = (float*)(ws + WS_XRES);
        bf16raw* Qb = (bf16raw*)(ws + WS_Q); bf16raw* Kb = (bf16raw*)(ws + WS_K); bf16raw* Vb = (bf16raw*)(ws + WS_V); bf16raw* XRb = (bf16raw*)(ws + WS_XR);
        bf16raw* YG = (bf16raw*)(ws + WS_YG); bf16raw* GA = (bf16raw*)(ws + WS_GA); bf16raw* GR = (bf16raw*)(ws + WS_GR);
        bf16raw* AO = (bf16raw*)(ws + WS_AO); bf16raw* HG = (bf16raw*)(ws + WS_HG); bf16raw* YA = (bf16raw*)(ws + WS_YA); bf16raw* MG = (bf16raw*)(ws + WS_MG);
        bf16raw* XS = (bf16raw*)(ws + WS_XS); bf16raw* HID = (bf16raw*)(ws + WS_HID); bf16raw* YB = (bf16raw*)(ws + WS_YB);
        {
            const int l = (ph - 1) / 10, s = (ph - 1) % 10;
            if (s == 6) continue;
            const float* xin = l == 0 ? P.in[0] : XRES;
            if (s == 0 && PH_ON(0)) {
                if (EN_MIX) {
                    pg8::Gemm g{XB, (const bf16raw*)(ws + WS_WIN) + (size_t)l * NIN * DM, TOK, NIN, DM}; pg8::StaticOrder S; S.init(TOK, NIN, G, bx);
                    pg8::EpiInProj E{Qb, Kb, Vb, XRb, YG, GA, GR, (const float*)(ws + WS_RCOS), (const float*)(ws + WS_RSIN)};
                    pg8::gemm_phase<pg8::EpiInProj, pg8::StaticOrder, true, true>(lds, g, S, E);
                }
            } else if (s == 1 && PH_ON(1)) {
                if (EN_ATTN && (sub & 1)) {
                    attn::Seam<attn::bf16> SM;
                    const attn::BlockRef<attn::bf16, attn::bf16> b0 = attn_block(P, l, 2 * vcu), b1 = attn_block(P, l, 2 * vcu + 1);
                    attn::causal_swa_prime<attn::bf16, attn::bf16>(b0, WIN, (char*)lds_raw, SM);
                    attn::causal_swa_block<attn::bf16, attn::bf16>(b0, b1, SEQ, WIN, (char*)lds_raw, SM);
                    attn::causal_swa_block<attn::bf16, attn::bf16>(b1, b1, SEQ, WIN, (char*)lds_raw, SM);
                    __syncthreads();
                }
                if (EN_RNN && (sub & 2)) {
                    scan_phase<false>(P, lds, l, vcu, G, tid, wave, lane);
                }
            } else if (s == 2 && PH_ON(2)) {
                if (EN_RNN && (sub & 2)) carry_prep(P, lds, vcu, G, tid);
                if (EN_ATTN && (sub & 1)) {
                    pg8::Gemm g{AO, (const bf16raw*)(ws + WS_WAO) + (size_t)l * DM * DM, TOK, DM, DM}; pg8::StaticOrder S; S.init(TOK, DM, G, bx);
                    pg8::EpiGate E{GA, nullptr, YA};
                    pg8::gemm_phase<pg8::EpiGate, pg8::StaticOrder, true, true>(lds, g, S, E);
                    __syncthreads();
                }
                if (EN_RNN && (sub & 2)) {
                    scan_phase<true>(P, lds, l, vcu, G, tid, wave, lane);
                }
            } else if (s == 3 && PH_ON(3)) {
                if (EN_RNN) {
                    pg8::Gemm g{HG, (const bf16raw*)(ws + WS_WRO) + (size_t)l * DM * DM, TOK, DM, DM}; pg8::StaticOrder S; S.init(TOK, DM, G, bx);
                    pg8::EpiGate E{GR, EN_ATTN ? YA : nullptr, MG};
                    pg8::gemm_phase<pg8::EpiGate, pg8::StaticOrder, true, true>(lds, g, S, E);
                }
            } else if (s == 4 && PH_ON(4)) {
                if (EN_MIX) {
                    pg8::Gemm g{EN_RNN ? MG : YA, (const bf16raw*)(ws + WS_WOUT) + (size_t)l * DM * DM, TOK, DM, DM}; pg8::StaticOrder S; S.init(TOK, DM, G, bx);
                    pg8::EpiResid E{xin, X1, ALPHA};
                    pg8::gemm_phase<pg8::EpiResid, pg8::StaticOrder, true, true>(lds, g, S, E);
                } else resid_only_phase(P, xin, vcu, G, wave, lane);
            } else if (s == 5 && PH_ON(5)) {
                ln1_router_phase(P, lds, l, vcu, G, tid, wave, lane);
            } else if (s == 7 && PH_ON(7)) {
                if (EN_MOE) {
                    const int nt = moe_tables(P, lds, l, tid);
                    const LAS int* T = (const LAS int*)(lds + LDS_CARRY);
                    const pg8::MoeTables MT{T + MT_TILEE, T + MT_TFIRST, T + MT_CNT, (const int*)(ws + WS_SLOT2), (const float*)(ws + WS_ROWW2)};
                    pg8::Gemm g{XB, (const bf16raw*)(ws + WS_WGU) + (size_t)l * NEXP * 1024 * DM, nt * 256, 1024, DM}; pg8::MoeOrder S{MT, nt * 4, G, vcu, DM * 2};
                    pg8::EpiSwiGLU E{HID};
                    pg8::gemm_phase<pg8::EpiSwiGLU, pg8::MoeOrder, true, true, true>(lds, g, S, E);
                }
            } else if (s == 8 && PH_ON(8)) {
                if (EN_MOE) {
                    const int nt = moe_tables(P, lds, l, tid);
                    const LAS int* T = (const LAS int*)(lds + LDS_CARRY);
                    const pg8::MoeTables MT{T + MT_TILEE, T + MT_TFIRST, T + MT_CNT, (const int*)(ws + WS_SLOT2), (const float*)(ws + WS_ROWW2)};
                    pg8::Gemm g{HID, (const bf16raw*)(ws + WS_WD) + (size_t)l * NEXP * DM * DEXP, nt * 256, 1024, DEXP}; pg8::MoeOrder S{MT, nt * 4, G, vcu, DEXP * 2};
                    pg8::EpiDown E{MT, YB};
                    pg8::gemm_phase<pg8::EpiDown, pg8::MoeOrder, true, true>(lds, g, S, E);
                }
            } else if (PH_ON(9)) {
                ln2_phase(P, l, l == DEPTH - 1 ? P.out : XRES, EN_MOE != 0, vcu, G, wave, lane);
            }
        }
        if (ph + 1 < hi) { xcd_barrier(bar);
#if defined(BAR_TWICE)
            xcd_barrier(bar);
#endif
        }
    }
}

extern "C" void kernel_launch(void* const* d_in, const int* in_sizes, int n_in, void* d_out, int out_size, void* d_ws, size_t ws_size, hipStream_t stream) {
    static int grid = 0;
    if (grid == 0) {
        if (n_in != 22 || in_sizes[0] != TOK * DM || out_size != TOK * DM || ws_size < WS_END) { fprintf(stderr, "kernel_launch: unexpected shapes (n_in %d, in0 %d, out %d, ws %zu)\n", n_in, n_in > 0 ? in_sizes[0] : -1, out_size, ws_size); grid = -1; return; }
        int dev = 0, cus = 0, per_cu = 0;
        if (hipGetDevice(&dev) != hipSuccess || hipDeviceGetAttribute(&cus, hipDeviceAttributeMultiprocessorCount, dev) != hipSuccess) { grid = -1; return; }
        if (hipFuncSetAttribute((const void*)fwd_kernel, hipFuncAttributeMaxDynamicSharedMemorySize, LDS_BYTES) != hipSuccess) { fprintf(stderr, "kernel_launch: hipFuncSetAttribute failed\n"); grid = -1; return; }
        if (hipOccupancyMaxActiveBlocksPerMultiprocessor(&per_cu, (const void*)fwd_kernel, NTHREADS, LDS_BYTES) != hipSuccess || per_cu < 1) fprintf(stderr, "kernel_launch: occupancy query reports %d\n", per_cu);
        (void)hipGetLastError();
        grid = cus;
        if (grid != 256) { fprintf(stderr, "kernel_launch: built for 256 CUs, device has %d\n", cus); grid = -1; return; }
    }
    if (grid < 0) return;
    if (hipMemsetAsync((char*)d_ws + WS_CTL, 0, CTL_ZERO_BYTES, stream) != hipSuccess) { fprintf(stderr, "kernel_launch: hipMemsetAsync failed\n"); return; }
    Args a{};
    for (int i = 0; i < 22; ++i) a.in[i] = (const float*)d_in[i];
    a.out = (float*)d_out; a.ws = (unsigned char*)d_ws;
#if MK_ONE_LAUNCH
    a.ph_lo = 0; a.ph_hi = N_PHASES; a.sub = 3;
    void* params[] = {&a};
    const hipError_t le = hipLaunchCooperativeKernel((const void*)fwd_kernel, dim3(grid), dim3(NTHREADS), params, LDS_BYTES, stream);
    if (le != hipSuccess) fprintf(stderr, "kernel_launch: cooperative launch failed: %s\n", hipGetErrorName(le));
#else
    for (int ph = 0; ph < N_PHASES; ++ph) {
        a.ph_lo = ph; a.ph_hi = ph + 1;
        const int s = ph == 0 ? 10 : (ph - 1) % 10;
        if (REP_MASK != 0 && (s == 1 || s == 2)) {
            for (int part = 1; part <= 2; ++part) { a.sub = part; const int bit = s == 1 ? 10 + part : 12 + part;
                for (int rep = 0; rep < REPS(bit) * REPS(s); ++rep) hipLaunchKernelGGL(fwd_kernel, dim3(grid), dim3(NTHREADS), LDS_BYTES, stream, a); }
        } else { a.sub = 3; for (int rep = 0; rep < REPS(s); ++rep) hipLaunchKernelGGL(fwd_kernel, dim3(grid), dim3(NTHREADS), LDS_BYTES, stream, a); }
    }
#endif
}
```
